# Optimizing an MI355X kernel written in HIP

```python
import math
import jax, jax.numpy as jnp
from jax import lax
import numpy as np

D_MODEL = 1024
BATCH = 16
SEQ = 256
DEPTH = 2
DEC_BATCH = 8
DEC_SEQ = 2048
PAST_LEN = 512

GRID_W = 64
N_HEADS = 8
HEAD_DIM = 64
V_DIM = 2 * HEAD_DIM
QK_WIDTH = N_HEADS * 2 * HEAD_DIM
ATTN_WIDTH = N_HEADS * V_DIM
POOL_WINDOWS = (2, 4, 8, 16)
POOL_GROUP = 128
POOL_WIDTH = POOL_GROUP * len(POOL_WINDOWS)
FOURIER_GROUPS = 4
FOURIER_GROUP = 128
FOURIER_WIDTH = FOURIER_GROUPS * FOURIER_GROUP
IN_WIDTH = 2 * QK_WIDTH + ATTN_WIDTH + POOL_WIDTH + FOURIER_WIDTH
D_FF = 2816
N_MOD = 9
ROPE_BASE = 10000.0
Q_BLOCK = 128
EPS = 1e-6

kernel_name = 'hybrid_diffattn_pool_fourier_prefix_step'


def rms_norm(x, g):
    xf = x.astype(jnp.float32)
    y = xf * lax.rsqrt(jnp.mean(xf * xf, axis=-1, keepdims=True) + EPS)
    return (y * g.astype(jnp.float32)).astype(x.dtype)


def modulate(x, g, shift, scale):
    return rms_norm(x, g) * (1 + scale) + shift


def swiglu(h, w13, w2):
    gate, up = jnp.split(h @ w13, 2, axis=-1)
    return (jax.nn.silu(gate) * up) @ w2


def axial_rope_tables(L):
    rows = L // GRID_W
    row = jnp.repeat(jnp.arange(rows), GRID_W).astype(jnp.float32)
    col = jnp.tile(jnp.arange(GRID_W), rows).astype(jnp.float32)
    n_freq = HEAD_DIM // 4
    inv = ROPE_BASE ** (-jnp.arange(n_freq, dtype=jnp.float32) / n_freq)
    ang = jnp.stack([row[:, None] * inv, col[:, None] * inv], axis=1)
    return jnp.cos(ang), jnp.sin(ang)


def apply_axial_rope(x, cos, sin):
    B, L = x.shape[:2]
    xr = x.reshape(B, L, N_HEADS, 2, 2, 2, HEAD_DIM // 4)
    x1, x2 = xr[..., 0, :], xr[..., 1, :]
    c = cos[None, :, None, None]
    s = sin[None, :, None, None]
    out = jnp.stack([x1 * c - x2 * s, x1 * s + x2 * c], axis=-2)
    return out.reshape(x.shape).astype(x.dtype)


def diff_attention(q, k, v, lam):
    B, Lq = q.shape[:2]
    nb = Lq // Q_BLOCK
    qb = jnp.moveaxis(q.reshape(B, nb, Q_BLOCK, N_HEADS, 2, HEAD_DIM), 1, 0)
    kf = k.astype(jnp.float32)
    vf = v.astype(jnp.float32)
    lam_f = lam.astype(jnp.float32)
    scale = HEAD_DIM ** -0.5

    def block(qblk):
        s = jnp.einsum('bqhnd,bkhnd->bnhqk', qblk.astype(jnp.float32), kf) * scale
        p = jax.nn.softmax(s, axis=-1)
        a = p[:, 0] - lam_f * p[:, 1]
        return jnp.einsum('bhqk,bkhe->bqhe', a, vf)

    o = lax.map(block, qb)
    return jnp.moveaxis(o, 0, 1).reshape(B, Lq, N_HEADS, V_DIM).astype(v.dtype)


def pool_mix(u, w_pool, pool_scale):
    B, L, _ = u.shape
    G = len(POOL_WINDOWS)
    uf = u.astype(jnp.float32).reshape(B, L, G, POOL_GROUP)
    cs = jnp.concatenate([jnp.zeros((B, 1, G, POOL_GROUP), jnp.float32), jnp.cumsum(uf, axis=1)], axis=1)
    t = jnp.arange(L)
    outs = []
    for g, w in enumerate(POOL_WINDOWS):
        lo = jnp.clip(t - w // 2, 0, L)
        hi = jnp.clip(t + w // 2, 0, L)
        csg = cs[:, :, g]
        win_sum = jnp.take(csg, hi, axis=1) - jnp.take(csg, lo, axis=1)
        cnt = (hi - lo).astype(jnp.float32)[None, :, None]
        d = win_sum / cnt - uf[:, :, g]
        outs.append(jnp.einsum('blc,cd->bld', d, w_pool[g].astype(jnp.float32)))
    y = jnp.concatenate(outs, axis=-1) * pool_scale.astype(jnp.float32)
    return y.astype(u.dtype)


def fourier_mix(u):
    B, L, _ = u.shape
    uf = u.astype(jnp.float32).reshape(B, L, FOURIER_GROUPS, FOURIER_GROUP)
    y = jnp.fft.fft2(uf, axes=(1, 3), norm='ortho').real
    return y.reshape(B, L, FOURIER_WIDTH).astype(u.dtype)


def token_mixer(h, ctx_k, ctx_v, lam_init, w_in, q_norm_g, k_norm_g, lam_qk, subln_g,
                w_pool, pool_scale, w_gate, w_pa, w_pp, w_pf, w_out):
    B, L, _ = h.shape
    proj = h @ w_in
    q, k, v, up, uf = jnp.split(
        proj, [QK_WIDTH, 2 * QK_WIDTH, 2 * QK_WIDTH + ATTN_WIDTH,
               2 * QK_WIDTH + ATTN_WIDTH + POOL_WIDTH], axis=-1)
    q = rms_norm(q.reshape(B, L, N_HEADS, 2, HEAD_DIM), q_norm_g)
    k = rms_norm(k.reshape(B, L, N_HEADS, 2, HEAD_DIM), k_norm_g)
    v = v.reshape(B, L, N_HEADS, V_DIM)
    if ctx_k is None:
        k_all, v_all = k, v
        k_out, v_out = k.reshape(B, L, N_HEADS, 2 * HEAD_DIM), v
    else:
        cos, sin = axial_rope_tables(L)
        q = apply_axial_rope(q, cos, sin)
        k = apply_axial_rope(k, cos, sin)
        P = ctx_k.shape[1]
        k_all = jnp.concatenate([ctx_k.reshape(B, P, N_HEADS, 2, HEAD_DIM).astype(k.dtype), k], axis=1)
        v_all = jnp.concatenate([ctx_v.astype(v.dtype), v], axis=1)
        k_out, v_out = None, None
    lq = lam_qk.astype(jnp.float32)
    lam = jnp.exp(jnp.sum(lq[0] * lq[1])) - jnp.exp(jnp.sum(lq[2] * lq[3])) + lam_init
    o = diff_attention(q, k_all, v_all, lam)
    a = (rms_norm(o, subln_g) * (1 - lam_init)).reshape(B, L, ATTN_WIDTH)
    p = pool_mix(up, w_pool, pool_scale)
    f = fourier_mix(uf)
    ga, gp, gf = jnp.split(jax.nn.sigmoid(h @ w_gate), 3, axis=-1)
    m = ga * (a @ w_pa) + gp * (p @ w_pp) + gf * (f @ w_pf)
    return m @ w_out, k_out, v_out


def trunk_layer(x, cond, ctx_k, ctx_v, lam_init, w_ada, b_ada, norm_g, ffn_w13, ffn_w2, w_in,
                q_norm_g, k_norm_g, lam_qk, subln_g, w_pool, pool_scale, w_gate, w_pa, w_pp, w_pf, w_out):
    mod = (jax.nn.silu(cond) @ w_ada + b_ada).reshape(cond.shape[0], 1, N_MOD, D_MODEL)
    h = modulate(x, norm_g[0], mod[:, :, 0], mod[:, :, 1])
    x = x + 0.5 * mod[:, :, 2] * swiglu(h, ffn_w13[0], ffn_w2[0])
    h = modulate(x, norm_g[1], mod[:, :, 3], mod[:, :, 4])
    m, k_out, v_out = token_mixer(h, ctx_k, ctx_v, lam_init, w_in, q_norm_g, k_norm_g, lam_qk, subln_g,
                                  w_pool, pool_scale, w_gate, w_pa, w_pp, w_pf, w_out)
    x = x + mod[:, :, 5] * m
    h = modulate(x, norm_g[2], mod[:, :, 6], mod[:, :, 7])
    x = x + 0.5 * mod[:, :, 8] * swiglu(h, ffn_w13[1], ffn_w2[1])
    return x, k_out, v_out


def setup_inputs(seed: int = 0) -> dict:
    key = jax.random.key(seed)
    ks = jax.random.split(key, 24)
    D = D_MODEL

    def nrm(k, shape, scale):
        return jax.random.normal(k, shape, jnp.float32) * scale

    return {
        'x_prompt': nrm(ks[0], (BATCH, SEQ, D), 1.0),
        'x_sample': nrm(ks[1], (DEC_BATCH, DEC_SEQ, D), 1.0),
        'cache_k': nrm(ks[2], (DEC_BATCH, DEPTH, PAST_LEN, N_HEADS, 2 * HEAD_DIM), 1.0),
        'cache_v': nrm(ks[3], (DEC_BATCH, DEPTH, PAST_LEN, N_HEADS, V_DIM), 1.0),
        'c': nrm(ks[4], (DEC_BATCH, D), 1.0),
        'c_ctx': nrm(ks[5], (D,), 1.0),
        'w_ada': nrm(ks[6], (DEPTH, D, N_MOD * D), 0.5 * D ** -0.5),
        'b_ada': nrm(ks[7], (DEPTH, N_MOD * D), 0.02),
        'norm_g': 1.0 + nrm(ks[8], (DEPTH, 3, D), 0.02),
        'ffn_w13': nrm(ks[9], (DEPTH, 2, D, 2 * D_FF), D ** -0.5),
        'ffn_w2': nrm(ks[10], (DEPTH, 2, D_FF, D), D_FF ** -0.5),
        'w_in': nrm(ks[11], (DEPTH, D, IN_WIDTH), D ** -0.5),
        'q_norm_g': 1.0 + nrm(ks[12], (DEPTH, HEAD_DIM), 0.02),
        'k_norm_g': 1.0 + nrm(ks[13], (DEPTH, HEAD_DIM), 0.02),
        'lam_qk': nrm(ks[14], (DEPTH, 4, HEAD_DIM), 0.1),
        'subln_g': 1.0 + nrm(ks[15], (DEPTH, V_DIM), 0.02),
        'w_pool': nrm(ks[16], (DEPTH, len(POOL_WINDOWS), POOL_GROUP, POOL_GROUP), POOL_GROUP ** -0.5),
        'pool_scale': 1.0 + nrm(ks[17], (DEPTH, POOL_WIDTH), 0.02),
        'w_gate': nrm(ks[18], (DEPTH, D, 3 * D), D ** -0.5),
        'w_pa': nrm(ks[19], (DEPTH, ATTN_WIDTH, D), ATTN_WIDTH ** -0.5),
        'w_pp': nrm(ks[20], (DEPTH, POOL_WIDTH, D), POOL_WIDTH ** -0.5),
        'w_pf': nrm(ks[21], (DEPTH, FOURIER_WIDTH, D), FOURIER_WIDTH ** -0.5),
        'w_out': nrm(ks[22], (DEPTH, D, D), D ** -0.5),
    }


def reference(x_prompt, x_sample, cache_k, cache_v, c, c_ctx, w_ada, b_ada, norm_g, ffn_w13, ffn_w2,
              w_in, q_norm_g, k_norm_g, lam_qk, subln_g, w_pool, pool_scale, w_gate, w_pa, w_pp, w_pf, w_out):
    cond_ctx = c_ctx[None]
    xp, xs = x_prompt, x_sample
    new_k, new_v = [], []
    for l in range(DEPTH):
        lam_init = 0.8 - 0.6 * math.exp(-0.3 * l)
        xp, k_l, v_l = trunk_layer(
            xp, cond_ctx, None, None, lam_init, w_ada[l], b_ada[l], norm_g[l], ffn_w13[l], ffn_w2[l],
            w_in[l], q_norm_g[l], k_norm_g[l], lam_qk[l], subln_g[l], w_pool[l], pool_scale[l],
            w_gate[l], w_pa[l], w_pp[l], w_pf[l], w_out[l])
        new_k.append(k_l)
        new_v.append(v_l)
        xs, _, _ = trunk_layer(
            xs, c, cache_k[:, l], cache_v[:, l], lam_init, w_ada[l], b_ada[l], norm_g[l], ffn_w13[l],
            ffn_w2[l], w_in[l], q_norm_g[l], k_norm_g[l], lam_qk[l], subln_g[l], w_pool[l], pool_scale[l],
            w_gate[l], w_pa[l], w_pp[l], w_pf[l], w_out[l])
    state_k = jnp.stack(new_k, axis=1)
    state_v = jnp.stack(new_v, axis=1)
    return (xp, xs, state_k, state_v)
```

```cpp
#include <hip/hip_runtime.h>
#include <hip/hip_bf16.h>
#include <hip/hip_cooperative_groups.h>
#include <cstdio>
#include <cstdint>
#include <cmath>
namespace cg = cooperative_groups;
namespace pg8 {
#define PG8_LAS __attribute__((address_space(3)))
typedef unsigned short bf16_t;
typedef short bf16x8 __attribute__((ext_vector_type(8)));
typedef float f32x4 __attribute__((ext_vector_type(4)));
typedef unsigned u32x4 __attribute__((ext_vector_type(4)));
constexpr int BM = 256, BK = 64, HALF = 128, HTB = HALF * BK * 2  , STAGE_BYTES = 8 * HTB, NXCD = 8, WGM = 8;

__host__ __device__ __forceinline__ int lds_byte(int r, int c) { const int st = (r >> 4) * 2 + (c >> 5), rr = r & 15, cc = c & 31, ob = rr * 64 + cc * 2; return st * 1024 + (ob ^ (((ob >> 9) & 1) << 5)); }
__host__ __device__ __forceinline__ void stage_rc(int b, int& R, int& C) { const int st = b / 1024, sb = b % 1024, swz = sb ^ (((sb >> 9) & 1) << 5); R = (st >> 1) * 16 + swz / 64; C = (st & 1) * 32 + (swz % 64) / 2; }
__host__ __device__ __forceinline__ int perm32(int rho) { const int n = rho >> 4, i = rho & 15; return 8 * (i >> 2) + 4 * n + (i & 3); }

struct Unit { int pm, pn, half, nhalf; };
struct Gemm { const bf16_t* A; const bf16_t* Bt; int M, N, K; };

struct StaticOrder {
    int nM, nN, nwg, G, c;
    __host__ __device__ void init(int M, int N, int G_, int c_) { nM = M / BM; nN = N / BM; nwg = nM * nN; G = G_; c = c_; }
    __host__ __device__ bool next(int i, Unit& u) const {
        const long L = (long)i * G + c; if (L >= nwg) return false;
        int wgid = (int)L; { const int q = nwg / NXCD, r = nwg % NXCD, xcd = wgid % NXCD, off = wgid / NXCD; wgid = (xcd < r ? xcd * (q + 1) : r * (q + 1) + (xcd - r) * q) + off; }
        const int nig = WGM * nN, gid = wgid / nig, fm = gid * WGM, gsz = (nM - fm) < WGM ? (nM - fm) : WGM;
        u.pm = fm + ((wgid % nig) % gsz); u.pn = (wgid % nig) / gsz; u.half = -1; u.nhalf = -1; return true;
    }
    __device__ __forceinline__ void a_ready(const Unit&) const {}
    __device__ __forceinline__ void done(const Unit&) const {}
};
struct HalfOrder {
    int c;
    __device__ void init(int c_) { c = c_; }
    __device__ bool next(int i, Unit& u) const {
        const int xcd = c & 7, idx = c >> 3, su = xcd * 8 + (idx >> 2), q = idx & 3;
        if (i == 0) { u.pm = su; u.pn = q; u.half = -1; u.nhalf = -1; return true; }
        if (i == 1) { u.pm = 64 + (su >> 2); u.pn = su & 3; u.half = q >> 1; u.nhalf = q & 1; return true; }
        return false;
    }
    __device__ __forceinline__ void a_ready(const Unit&) const {}
    __device__ __forceinline__ void done(const Unit&) const {}
};


constexpr int T_TOK = 20480, T_PR = 4096, DM = 1024, FFD = 2816;
typedef unsigned u32x2 __attribute__((ext_vector_type(2)));
__device__ __forceinline__ unsigned cvt_pk_bf16(float lo, float hi) { unsigned r; asm volatile("v_cvt_pk_bf16_f32 %0, %1, %2" : "=v"(r) : "v"(lo), "v"(hi)); return r; }
__device__ __forceinline__ float bf_lo(unsigned w) { return __uint_as_float(w << 16); }
__device__ __forceinline__ float bf_hi(unsigned w) { return __uint_as_float(w & 0xffff0000u); }
__device__ __forceinline__ int cond_of_pm(int pm) { return pm < 16 ? 8 : ((pm - 16) >> 3); }
__device__ __forceinline__ float sigmoidf_(float x) { return __builtin_amdgcn_rcpf(1.0f + __builtin_amdgcn_exp2f(-1.4426950408889634f * x)); }


struct EpiSwiglu {
    static constexpr bool PERM = true, AFTER_DRAIN = false;
    bf16_t* O;
    __device__ __forceinline__ void operator()(const f32x4 (&acc)[2][2][4][2], const Unit& u, int wr, int wc, int fr, int fq) const {
        asm volatile("" : "+v"(fr), "+v"(fq));
        const int row0 = u.pm * BM + wr * 64 + fr, col0 = u.pn * 128 + wc * 32 + 8 * fq;
#pragma unroll
        for (int ai = 0; ai < 2; ++ai)
#pragma unroll
            for (int m = 0; m < 4; ++m) {
                bf16_t* rowp = O + (size_t)(row0 + ai * HALF + m * 16) * FFD + col0;
                float v[8];
#pragma unroll
                for (int n = 0; n < 2; ++n)
#pragma unroll
                    for (int j = 0; j < 4; ++j) { const float g = acc[ai][0][m][n][j], up = acc[ai][1][m][n][j]; v[n * 4 + j] = g * sigmoidf_(g) * up; }
                u32x4 w; w.x = cvt_pk_bf16(v[0], v[1]); w.y = cvt_pk_bf16(v[2], v[3]); w.z = cvt_pk_bf16(v[4], v[5]); w.w = cvt_pk_bf16(v[6], v[7]);
                *(u32x4*)rowp = w;
            }
    }
};

struct EpiResid {
    static constexpr bool PERM = false, AFTER_DRAIN = false;
    const float* base; float* out; const float* gate; float gs;
    __device__ __forceinline__ void operator()(const f32x4 (&acc)[2][2][4][2], const Unit& u, int wr, int wc, int fr, int fq) const {
        asm volatile("" : "+v"(fr), "+v"(fq));
        const float* gv = gate + (size_t)cond_of_pm(u.pm) * 9216;
        const int col0 = u.pn * BM + (u.nhalf == 1 ? HALF : 0) + wc * 32 + 4 * fq;
        f32x4 g4[2][2];
#pragma unroll
        for (int bj = 0; bj < 2; ++bj)
#pragma unroll
            for (int n = 0; n < 2; ++n) g4[bj][n] = *(const f32x4*)(gv + col0 + bj * HALF + n * 16) * gs;
#pragma unroll
        for (int ai = 0; ai < 2; ++ai)
#pragma unroll
            for (int m = 0; m < 4; ++m) { if (ai == 1 && u.half >= 0) break;
                const size_t off = (size_t)(u.pm * BM + (u.half == 1 ? HALF : 0) + ai * HALF + wr * 64 + m * 16 + fr) * DM + col0;
#pragma unroll
                for (int bj = 0; bj < 2; ++bj) { if (bj == 1 && u.nhalf >= 0) break;
#pragma unroll
                    for (int n = 0; n < 2; ++n) { const f32x4 b = __builtin_nontemporal_load((const f32x4*)(base + off + bj * HALF + n * 16));
                        __builtin_nontemporal_store(b + g4[bj][n] * acc[ai][bj][m][n], (f32x4*)(out + off + bj * HALF + n * 16)); } }
            }
    }
};

struct EpiDelta {
    static constexpr bool PERM = true, AFTER_DRAIN = false;
    bf16_t* DL; const float* gate; float gs;
    __device__ __forceinline__ void operator()(const f32x4 (&acc)[2][2][4][2], const Unit& u, int wr, int wc, int fr, int fq) const {
        asm volatile("" : "+v"(fr), "+v"(fq));
        const float* gv = gate + (size_t)cond_of_pm(u.pm) * 9216;
        const int row0 = u.pm * BM + (u.half == 1 ? HALF : 0) + wr * 64 + fr, col0 = u.pn * BM + (u.nhalf == 1 ? HALF : 0) + wc * 32 + 8 * fq;
        f32x4 g4[2][2];
#pragma unroll
        for (int bj = 0; bj < 2; ++bj)
#pragma unroll
            for (int n = 0; n < 2; ++n) g4[bj][n] = *(const f32x4*)(gv + col0 + bj * HALF + n * 4) * gs;
#pragma unroll
        for (int ai = 0; ai < 2; ++ai)
#pragma unroll
            for (int m = 0; m < 4; ++m) { if (ai == 1 && u.half >= 0) break;
                bf16_t* rowp = DL + (size_t)(row0 + ai * HALF + m * 16) * DM + col0;
#pragma unroll
                for (int bj = 0; bj < 2; ++bj) { if (bj == 1 && u.nhalf >= 0) break;
                    const f32x4 v0 = g4[bj][0] * acc[ai][bj][m][0], v1 = g4[bj][1] * acc[ai][bj][m][1];
                    u32x4 w; w.x = cvt_pk_bf16(v0[0], v0[1]); w.y = cvt_pk_bf16(v0[2], v0[3]); w.z = cvt_pk_bf16(v1[0], v1[1]); w.w = cvt_pk_bf16(v1[2], v1[3]);
                    *(u32x4*)(rowp + bj * HALF) = w; } }
    }
};

struct EpiProj {
    static constexpr bool PERM = true, AFTER_DRAIN = false;
    bf16_t *Q, *K, *V, *UP, *UTs, *UTp; float *stk, *stv; const float *qg, *kg;
    __device__ __forceinline__ void operator()(const f32x4 (&acc)[2][2][4][2], const Unit& u, int wr, int wc, int fr, int fq) const {
        asm volatile("" : "+v"(fr), "+v"(fq));
        const int pn = u.pn, pm = u.pm; const bool latent = pm >= 16; const int rt0 = wr * 64 + fr;
#ifndef PJ
#define PJ 7
#endif
        if (pn < 8 && (PJ & 1)) {
            const bool isk = pn >= 4; const int u64 = 4 * (pn & 3) + wc;
            const float* gsrc = isk ? kg : qg; bf16_t* dst = isk ? K : Q;
            f32x4 gv[2][2];
#pragma unroll
            for (int bj = 0; bj < 2; ++bj)
#pragma unroll
                for (int n = 0; n < 2; ++n) gv[bj][n] = *(const f32x4*)(gsrc + 32 * bj + 16 * n + 4 * fq);
            float invrev[4];
#pragma unroll
            for (int j = 0; j < 4; ++j) invrev[j] = __builtin_amdgcn_exp2f(-(float)(4 * fq + j) * (13.287712379549449f / 16.0f)) * 0.15915494309189535f;
#pragma unroll
            for (int ai = 0; ai < 2; ++ai)
#pragma unroll
                for (int m = 0; m < 4; ++m) {
                    const int rt = ai * HALF + rt0 + m * 16, row = pm * BM + rt;
                    float ss = 0.f;
#pragma unroll
                    for (int bj = 0; bj < 2; ++bj)
#pragma unroll
                        for (int n = 0; n < 2; ++n) { const f32x4 x = acc[ai][bj][m][n]; ss += (x[0] * x[0] + x[1] * x[1]) + (x[2] * x[2] + x[3] * x[3]); }
                    ss += __shfl_xor(ss, 16); ss += __shfl_xor(ss, 32);
                    const float rstd = __builtin_amdgcn_rsqf(ss * (1.0f / 64.0f) + 1e-6f);
                    f32x4 y[2][2];
#pragma unroll
                    for (int bj = 0; bj < 2; ++bj)
#pragma unroll
                        for (int n = 0; n < 2; ++n) y[bj][n] = acc[ai][bj][m][n] * rstd * gv[bj][n];
                    if (latent) {
                        const int s = (row - T_PR) & 2047;
#pragma unroll
                        for (int bj = 0; bj < 2; ++bj) { const float pos = (float)(bj == 0 ? (s >> 6) : (s & 63));
#pragma unroll
                            for (int j = 0; j < 4; ++j) { const float rv = __builtin_amdgcn_fractf(pos * invrev[j]);
                                const float sn = __builtin_amdgcn_sinf(rv), cs = __builtin_amdgcn_cosf(rv);
                                const float x1 = y[bj][0][j], x2 = y[bj][1][j]; y[bj][0][j] = x1 * cs - x2 * sn; y[bj][1][j] = x1 * sn + x2 * cs; } }
                    }
#pragma unroll
                    for (int bj = 0; bj < 2; ++bj)
#pragma unroll
                        for (int n = 0; n < 2; ++n) { const int col = 64 * u64 + 32 * bj + 16 * n + 4 * fq;
                            u32x2 w; w.x = cvt_pk_bf16(y[bj][n][0], y[bj][n][1]); w.y = cvt_pk_bf16(y[bj][n][2], y[bj][n][3]);
                            *(u32x2*)(dst + (size_t)row * DM + col) = w;
                            if (isk && !latent) __builtin_nontemporal_store(y[bj][n], (f32x4*)(stk + ((size_t)pm * 512 + rt) * DM + col)); }
                    asm volatile("" ::: "memory");
                }
        } else if (pn < 14 && (PJ & 2)) {
            const bool isv = pn < 12; bf16_t* dst = isv ? V : UP; const int ld = isv ? DM : 512; const int colt = (isv ? (pn - 8) : (pn - 12)) * BM + wc * 32 + 8 * fq;
#pragma unroll
            for (int ai = 0; ai < 2; ++ai)
#pragma unroll
                for (int m = 0; m < 4; ++m) { const int rt = ai * HALF + rt0 + m * 16, row = pm * BM + rt;
#pragma unroll
                    for (int bj = 0; bj < 2; ++bj) { const f32x4 v0 = acc[ai][bj][m][0], v1 = acc[ai][bj][m][1];
                        u32x4 w; w.x = cvt_pk_bf16(v0[0], v0[1]); w.y = cvt_pk_bf16(v0[2], v0[3]); w.z = cvt_pk_bf16(v1[0], v1[1]); w.w = cvt_pk_bf16(v1[2], v1[3]);
                        *(u32x4*)(dst + (size_t)row * ld + colt + bj * HALF) = w;
                        if (isv && !latent) { float* sp = stv + ((size_t)pm * 512 + rt) * DM + colt + bj * HALF; __builtin_nontemporal_store(v0, (f32x4*)sp); __builtin_nontemporal_store(v1, (f32x4*)(sp + 4)); } }
                    asm volatile("" ::: "memory");
                }
        } else if (PJ & 4) {
            bf16_t* dst; int ldl;
            if (latent) { const int b = (pm - 16) >> 3; dst = UTs + (size_t)b * 512 * 2048 + ((pm - 16) & 7) * BM; ldl = 2048; }
            else { dst = UTp + (size_t)pm * 512 * 256; ldl = 256; }
            const int c0 = (pn - 14) * BM + wc * 32 + 8 * fq;
#pragma unroll
            for (int ai = 0; ai < 2; ++ai)
#pragma unroll
                for (int m = 0; m < 4; ++m) { const int rt = ai * HALF + rt0 + m * 16;
#pragma unroll
                    for (int bj = 0; bj < 2; ++bj)
#pragma unroll
                        for (int n = 0; n < 2; ++n)
#pragma unroll
                            for (int j = 0; j < 4; j += 2) { const unsigned w = cvt_pk_bf16(acc[ai][bj][m][n][j], acc[ai][bj][m][n][j + 1]);
                                const int c = c0 + bj * HALF + 4 * n + j;
                                dst[(size_t)c * ldl + rt] = (bf16_t)(w & 0xffffu); dst[(size_t)(c + 1) * ldl + rt] = (bf16_t)(w >> 16); }
                    asm volatile("" ::: "memory");
                }
        }
    }
};

struct EpiFourier {
    static constexpr bool PERM = true, AFTER_DRAIN = false;
    bf16_t* Z; int lshift, tokbase, seqlen;
    __device__ __forceinline__ void operator()(const f32x4 (&acc)[2][2][4][2], const Unit& u, int wr, int wc, int fr, int fq) const {
        asm volatile("" : "+v"(fr), "+v"(fq));
        const int which = u.pm >> lshift, lt = u.pm & ((1 << lshift) - 1), b = u.pn >> 1, ct = u.pn & 1;
        const int row0 = tokbase + b * seqlen + lt * BM + wr * 64 + fr, col0 = which * 512 + ct * BM + wc * 32 + 8 * fq;
#pragma unroll
        for (int ai = 0; ai < 2; ++ai)
#pragma unroll
            for (int m = 0; m < 4; ++m) { bf16_t* rowp = Z + (size_t)(row0 + ai * HALF + m * 16) * DM + col0;
#pragma unroll
                for (int bj = 0; bj < 2; ++bj) { const f32x4 v0 = acc[ai][bj][m][0], v1 = acc[ai][bj][m][1];
                    u32x4 w; w.x = cvt_pk_bf16(v0[0], v0[1]); w.y = cvt_pk_bf16(v0[2], v0[3]); w.z = cvt_pk_bf16(v1[0], v1[1]); w.w = cvt_pk_bf16(v1[2], v1[3]);
                    *(u32x4*)(rowp + bj * HALF) = w; } }
    }
};

struct EpiMerge {
    static constexpr bool PERM = true, AFTER_DRAIN = false;
    bf16_t* G; bf16_t* TS; bf16_t* MB; int mode;
    __device__ __forceinline__ void operator()(const f32x4 (&acc)[2][2][4][2], const Unit& u, int wr, int wc, int fr, int fq) const {
        asm volatile("" : "+v"(fr), "+v"(fq));
        const int row0 = u.pm * BM + (u.half == 1 ? HALF : 0) + wr * 64 + fr, col0 = u.pn * BM + (u.nhalf == 1 ? HALF : 0) + wc * 32 + 8 * fq;
#pragma unroll
        for (int ai = 0; ai < 2; ++ai)
#pragma unroll
            for (int m = 0; m < 4; ++m) { if (ai == 1 && u.half >= 0) break;
                const size_t off = (size_t)(row0 + ai * HALF + m * 16) * DM + col0;
#pragma unroll
                for (int bj = 0; bj < 2; ++bj) { if (bj == 1 && u.nhalf >= 0) break;
                    const f32x4 v0 = acc[ai][bj][m][0], v1 = acc[ai][bj][m][1]; const size_t o = off + bj * HALF;
                    if (mode == 0) {
                        u32x4 w; w.x = cvt_pk_bf16(sigmoidf_(v0[0]), sigmoidf_(v0[1])); w.y = cvt_pk_bf16(sigmoidf_(v0[2]), sigmoidf_(v0[3]));
                        w.z = cvt_pk_bf16(sigmoidf_(v1[0]), sigmoidf_(v1[1])); w.w = cvt_pk_bf16(sigmoidf_(v1[2]), sigmoidf_(v1[3]));
                        *(u32x4*)(G + o) = w;
                    } else {
                        const u32x4 g = *(const u32x4*)(G + o);
                        f32x4 r0 = (f32x4){bf_lo(g.x), bf_hi(g.x), bf_lo(g.y), bf_hi(g.y)} * v0, r1 = (f32x4){bf_lo(g.z), bf_hi(g.z), bf_lo(g.w), bf_hi(g.w)} * v1;
                        if (mode >= 2) { const u32x4 t = *(const u32x4*)(TS + o);
                            r0 += (f32x4){bf_lo(t.x), bf_hi(t.x), bf_lo(t.y), bf_hi(t.y)}; r1 += (f32x4){bf_lo(t.z), bf_hi(t.z), bf_lo(t.w), bf_hi(t.w)}; }
                        { u32x4 w; w.x = cvt_pk_bf16(r0[0], r0[1]); w.y = cvt_pk_bf16(r0[2], r0[3]); w.z = cvt_pk_bf16(r1[0], r1[1]); w.w = cvt_pk_bf16(r1[2], r1[3]); *(u32x4*)((mode == 3 ? MB : TS) + o) = w; }
                    } } }
    }
};
template <class Epi, class Sched, bool ALIGN_EPI = false, bool SP2 = false>
__device__ __forceinline__ void gemm_phase(PG8_LAS unsigned char* lds, const Gemm g, const Sched& S, const Epi& E) {
    int tid_l = threadIdx.x; asm volatile("" : "+v"(tid_l));
    const int tid = tid_l, wid = __builtin_amdgcn_readfirstlane(tid >> 6), lane = tid & 63, wr = wid >> 2, wc = wid & 3, fr = lane & 15, fq = lane >> 4;
    const int K = g.K, nt = K / BK;
    unsigned voffA[2], voffB[2];
#pragma unroll
    for (int i = 0; i < 2; ++i) { int R, C; stage_rc(tid * 16 + i * 8192, R, C); const int Rb = Epi::PERM ? ((R & ~31) + perm32(R & 31)) : R;
        voffA[i] = (unsigned)(R * K + C) * 2u; voffB[i] = (unsigned)(Rb * K + C) * 2u; }
    const size_t kstep = (size_t)(BK * 2);
    const size_t hstep = (size_t)HALF * K * 2;
    const size_t tstep = 2 * hstep;
    const unsigned ldsw = (unsigned)wid * 1024u;
    const int aoff = lds_byte(wr * 64 + fr, fq * 8), boff = lds_byte(wc * 32 + fr, fq * 8);
#define PG8_SA(b, h) (((b) * 2 + (h)) * HTB)
#define PG8_SB(b, h) ((4 + (b) * 2 + (h)) * HTB)
#define PG8_STAGE(bufoff, gbase, voff) do { _Pragma("unroll") for (int _i = 0; _i < 2; ++_i) \
        __builtin_amdgcn_global_load_lds((const unsigned*)((const char*)(gbase) + (voff)[_i]), (PG8_LAS unsigned*)(lds + (bufoff) + ldsw + _i * 8192), 16, 0, 0); } while (0)
#define PG8_LDA(dst, b, h) do { _Pragma("unroll") for (int m = 0; m < 4; ++m) _Pragma("unroll") for (int k = 0; k < 2; ++k) dst[m][k] = *(const PG8_LAS bf16x8*)(lds + PG8_SA(b, h) + aoff + m * 2048 + k * 1024); } while (0)
#define PG8_LDB(dst, b, h) do { _Pragma("unroll") for (int n = 0; n < 2; ++n) _Pragma("unroll") for (int k = 0; k < 2; ++k) dst[n][k] = *(const PG8_LAS bf16x8*)(lds + PG8_SB(b, h) + boff + n * 2048 + k * 1024); } while (0)
#define PG8_MMA(ai, bj, At, Bt) do { __builtin_amdgcn_s_setprio(1); _Pragma("unroll") for (int m = 0; m < 4; ++m) _Pragma("unroll") for (int n = 0; n < 2; ++n) _Pragma("unroll") for (int k = 0; k < 2; ++k) \
        acc[ai][bj][m][n] = __builtin_amdgcn_mfma_f32_16x16x32_bf16(Bt[n][k], At[m][k], acc[ai][bj][m][n], 0, 0, 0); __builtin_amdgcn_s_setprio(0); } while (0)
#define PG8_WAIT_V(n) asm volatile("s_waitcnt vmcnt(" #n ")" ::: "memory")
#define PG8_WAIT_L(n) asm volatile("s_waitcnt lgkmcnt(" #n ")" ::: "memory")
#define PG8_BAR __builtin_amdgcn_s_barrier()
#define PG8_SCHED __builtin_amdgcn_sched_barrier(0)
    Unit cur, nxt; int ui = 0;
    if (!S.next(0, cur)) return;
    f32x4 acc[2][2][4][2];
#pragma unroll
    for (int a = 0; a < 2; ++a)
#pragma unroll
        for (int b = 0; b < 2; ++b)
#pragma unroll
            for (int m = 0; m < 4; ++m)
#pragma unroll
                for (int n = 0; n < 2; ++n) acc[a][b][m][n] = (f32x4){0.f, 0.f, 0.f, 0.f};
    bf16x8 At[4][2], B0[2][2], B1[2][2];
    const char* cA = (const char*)g.A + (size_t)cur.pm * tstep + (cur.half == 1 ? hstep : (size_t)0); const char* cB = (const char*)g.Bt + (size_t)cur.pn * tstep + (cur.nhalf == 1 ? hstep : (size_t)0);
    size_t cbh = cur.nhalf >= 0 ? (size_t)0 : hstep;
    size_t ch = cur.half >= 0 ? (size_t)0 : hstep;
    S.a_ready(cur);
    if constexpr (SP2) {
        PG8_STAGE(PG8_SB(0, 0), cB, voffB); PG8_STAGE(PG8_SB(0, 1), cB + cbh, voffB); PG8_STAGE(PG8_SA(0, 0), cA, voffA); PG8_STAGE(PG8_SA(0, 1), cA + ch, voffA);
        if (wr == 1) PG8_BAR;
        PG8_WAIT_V(2); PG8_BAR;
        PG8_STAGE(PG8_SB(1, 0), cB + kstep, voffB); PG8_STAGE(PG8_SA(1, 0), cA + kstep, voffA); PG8_STAGE(PG8_SB(1, 1), cB + cbh + kstep, voffB);
        PG8_WAIT_V(6); PG8_BAR;
    } else {
        PG8_STAGE(PG8_SB(0, 0), cB, voffB); PG8_STAGE(PG8_SA(0, 0), cA, voffA); PG8_STAGE(PG8_SB(0, 1), cB + cbh, voffB); PG8_STAGE(PG8_SA(0, 1), cA + ch, voffA);
        if (wr == 1) PG8_BAR;
        PG8_WAIT_V(4); PG8_BAR;
        PG8_STAGE(PG8_SB(1, 0), cB + kstep, voffB); PG8_STAGE(PG8_SA(1, 0), cA + kstep, voffA); PG8_STAGE(PG8_SB(1, 1), cB + cbh + kstep, voffB);
        PG8_WAIT_V(6); PG8_BAR;
    }
    for (;;) {
        const bool has_next = S.next(ui + 1, nxt);
        const char* nA = has_next ? (const char*)g.A + (size_t)nxt.pm * tstep + (nxt.half == 1 ? hstep : (size_t)0) : cA; const char* nB = has_next ? (const char*)g.Bt + (size_t)nxt.pn * tstep + (nxt.nhalf == 1 ? hstep : (size_t)0) : cB;
        const size_t nh = has_next ? (nxt.half >= 0 ? (size_t)0 : hstep) : ch; const bool hm = cur.half >= 0;
        const size_t nbh = has_next ? (nxt.nhalf >= 0 ? (size_t)0 : hstep) : cbh; const bool nm = cur.nhalf >= 0;
        for (int t = 0; t < nt; t += 2) {
            const bool last = (t == nt - 2);
            const char* a1 = cA + (size_t)(t + 1) * kstep;
            const char* a2 = last ? nA : cA + (size_t)(t + 2) * kstep; const char* b2 = last ? nB : cB + (size_t)(t + 2) * kstep;
            const char* a3 = a2 + kstep; const char* b3 = b2 + kstep;
            if (last && has_next) S.a_ready(nxt);
            if constexpr (SP2) {
            PG8_LDB(B0, 0, 0); if (!nm) { PG8_LDB(B1, 0, 1); } PG8_SCHED; PG8_LDA(At, 0, 0); PG8_STAGE(PG8_SA(1, 1), a1 + ch, voffA);
            PG8_WAIT_V(8); PG8_WAIT_L(0); PG8_BAR; PG8_MMA(0, 0, At, B0); if (!nm) { PG8_MMA(0, 1, At, B1); } PG8_BAR; PG8_SCHED;
            if (!hm) { PG8_LDA(At, 0, 1); } PG8_STAGE(PG8_SB(0, 0), b2, voffB); PG8_STAGE(PG8_SB(0, 1), b2 + (last ? nbh : cbh), voffB); PG8_STAGE(PG8_SA(0, 0), a2, voffA);
            PG8_WAIT_V(8); PG8_WAIT_L(0); PG8_BAR; if (!hm) { PG8_MMA(1, 0, At, B0); if (!nm) { PG8_MMA(1, 1, At, B1); } } PG8_BAR; PG8_SCHED;
            PG8_LDB(B0, 1, 0); if (!nm) { PG8_LDB(B1, 1, 1); } PG8_SCHED; PG8_LDA(At, 1, 0); PG8_STAGE(PG8_SA(0, 1), a2 + (last ? nh : ch), voffA);
            PG8_WAIT_V(8); PG8_WAIT_L(0); PG8_BAR; PG8_MMA(0, 0, At, B0); if (!nm) { PG8_MMA(0, 1, At, B1); } PG8_BAR; PG8_SCHED;
            if (!hm) { PG8_LDA(At, 1, 1); } PG8_STAGE(PG8_SB(1, 0), b3, voffB); PG8_STAGE(PG8_SB(1, 1), b3 + (last ? nbh : cbh), voffB); PG8_STAGE(PG8_SA(1, 0), a3, voffA);
            PG8_WAIT_V(8); PG8_WAIT_L(0); PG8_BAR; if (!hm) { PG8_MMA(1, 0, At, B0); if (!nm) { PG8_MMA(1, 1, At, B1); } } PG8_BAR; PG8_SCHED;
            } else {
            PG8_LDB(B0, 0, 0); PG8_SCHED; PG8_LDA(At, 0, 0); PG8_STAGE(PG8_SA(1, 1), a1 + ch, voffA);
            PG8_WAIT_L(8); PG8_BAR; PG8_WAIT_L(0); PG8_MMA(0, 0, At, B0); PG8_BAR; PG8_SCHED;
            PG8_LDB(B1, 0, 1); PG8_STAGE(PG8_SB(0, 0), b2, voffB);
            PG8_BAR; PG8_WAIT_L(0); PG8_MMA(0, 1, At, B1); PG8_BAR;
            PG8_LDA(At, 0, 1); PG8_STAGE(PG8_SA(0, 0), a2, voffA);
            PG8_BAR; PG8_WAIT_L(0); PG8_MMA(1, 0, At, B0); PG8_BAR; PG8_SCHED;
            PG8_STAGE(PG8_SB(0, 1), b2 + (last ? nbh : cbh), voffB);
            PG8_WAIT_V(6); PG8_BAR; PG8_MMA(1, 1, At, B1); PG8_BAR;
            PG8_LDB(B0, 1, 0); PG8_SCHED; PG8_LDA(At, 1, 0); PG8_STAGE(PG8_SA(0, 1), a2 + (last ? nh : ch), voffA);
            PG8_WAIT_L(8); PG8_BAR; PG8_WAIT_L(0); PG8_MMA(0, 0, At, B0); PG8_BAR; PG8_SCHED;
            PG8_LDB(B1, 1, 1); PG8_STAGE(PG8_SB(1, 0), b3, voffB);
            PG8_BAR; PG8_WAIT_L(0); PG8_MMA(0, 1, At, B1); PG8_BAR;
            PG8_LDA(At, 1, 1); PG8_STAGE(PG8_SA(1, 0), a3, voffA);
            PG8_BAR; PG8_WAIT_L(0); PG8_MMA(1, 0, At, B0); PG8_BAR; PG8_SCHED;
            PG8_STAGE(PG8_SB(1, 1), b3 + (last ? nbh : cbh), voffB);
            PG8_WAIT_V(6); PG8_BAR; PG8_MMA(1, 1, At, B1); PG8_BAR;
            }
        }
        if constexpr (ALIGN_EPI) { if (wr == 0) PG8_BAR; }
        if constexpr (!Epi::AFTER_DRAIN) { E(acc, cur, wr, wc, fr, fq); S.done(cur); }
        if (!has_next) break;
#pragma unroll
        for (int a = 0; a < 2; ++a)
#pragma unroll
            for (int b = 0; b < 2; ++b)
#pragma unroll
                for (int m = 0; m < 4; ++m)
#pragma unroll
                    for (int n = 0; n < 2; ++n) acc[a][b][m][n] = (f32x4){0.f, 0.f, 0.f, 0.f};
        cur = nxt; cA = nA; cB = nB; ch = nh; cbh = nbh; ++ui;
        if constexpr (ALIGN_EPI) { if (wr == 1) PG8_BAR; }
    }
    PG8_WAIT_V(0);
    if constexpr (!ALIGN_EPI) { if (wr == 0) PG8_BAR; }
    PG8_BAR;
    if constexpr (Epi::AFTER_DRAIN) { E.fused(acc, cur, wr, wc, fr, fq, lds, wid, lane); S.done(cur); }
#undef PG8_SA
#undef PG8_SB
#undef PG8_STAGE
#undef PG8_LDA
#undef PG8_LDB
#undef PG8_MMA
#undef PG8_WAIT_V
#undef PG8_WAIT_L
#undef PG8_BAR
#undef PG8_SCHED
}
}

using pg8::sigmoidf_; using pg8::bf_lo; using pg8::bf_hi;
namespace att {
using bf16 = unsigned short;
using bf16x8 = __attribute__((ext_vector_type(8))) short;
using s16x4  = __attribute__((ext_vector_type(4))) short;
using f32x16 = __attribute__((ext_vector_type(16))) float;
using u32x4  = __attribute__((ext_vector_type(4))) unsigned;
constexpr int NW = 8, QBLK = 32, KVBLK = 64, LDK = 1024;
constexpr float SCALE = 0.125f, THR = 8.f;
constexpr int SHM_V = KVBLK * 128 * 2, SHM_K = KVBLK * 128 * 2, SHM_ATTN = 2 * SHM_V + 2 * SHM_K + NW * 64 * 4;
#define KSWZ(row, colB) ((row) * 256 + ((colB) ^ (((row) & 7) << 4)))
#define SBAR() __builtin_amdgcn_sched_barrier(0)
__device__ __forceinline__ int crow(int r, int hi) { return (r & 3) + 8 * (r >> 2) + 4 * hi; }
__device__ __forceinline__ unsigned cvtpk(float lo, float hi) { unsigned r; asm volatile("v_cvt_pk_bf16_f32 %0, %1, %2" : "=v"(r) : "v"(lo), "v"(hi)); return r; }
__device__ __forceinline__ bf16x8 ld8(const bf16* p) { return *reinterpret_cast<const bf16x8*>(p); }

__device__ __forceinline__ void partialSM(f32x16& p0, f32x16& p1, float& m_reg, float& mn, float& alpha) {
  constexpr float C = SCALE * 1.4426950408889634f;
  alpha = 1.f; mn = 0.f;
#pragma unroll
  for (int r = 0; r < 16; ++r) p0[r] = fmaf(p0[r], C, -8.0f);
#pragma unroll
  for (int r = 0; r < 16; ++r) p1[r] = fmaf(p1[r], C, -8.0f);
#pragma unroll
  for (int r = 0; r < 16; ++r) p0[r] = __builtin_amdgcn_exp2f(p0[r]);
}
__device__ __forceinline__ void finishSM(f32x16& p0, f32x16& p1, float alpha, float& l_reg, bf16x8& pa0, bf16x8& pa1, bf16x8& pa2, bf16x8& pa3) {
#pragma unroll
  for (int r = 0; r < 16; ++r) p1[r] = __builtin_amdgcn_exp2f(p1[r]);
  float ps = 0;
#pragma unroll
  for (int r = 0; r < 16; ++r) ps += p0[r];
#pragma unroll
  for (int r = 0; r < 16; ++r) ps += p1[r];
  { auto rr = __builtin_amdgcn_permlane32_swap(__float_as_uint(ps), __float_as_uint(ps), false, false);
    ps = __uint_as_float(rr[0]) + __uint_as_float(rr[1]); }
  l_reg = l_reg * alpha + ps;
#define PK4(P, BASE, OUT) do { unsigned a0 = cvtpk(P[BASE + 0], P[BASE + 1]), a1 = cvtpk(P[BASE + 2], P[BASE + 3]);   \
    unsigned b0 = cvtpk(P[BASE + 4], P[BASE + 5]), b1 = cvtpk(P[BASE + 6], P[BASE + 7]);                              \
    auto r0 = __builtin_amdgcn_permlane32_swap(a0, b0, false, false); auto r1 = __builtin_amdgcn_permlane32_swap(a1, b1, false, false); \
    u32x4 w = {r0[0], r1[0], r0[1], r1[1]}; OUT = *reinterpret_cast<bf16x8*>(&w); } while (0)
  PK4(p0, 0, pa0); PK4(p0, 8, pa1); PK4(p1, 0, pa2); PK4(p1, 8, pa3);
#undef PK4
}
__device__ __forceinline__ void qkt(f32x16& p0, f32x16& p1, const bf16* Ks, const bf16x8* qr, int r32, int hi, int map) {
  p0 = f32x16{}; p1 = f32x16{};
#pragma unroll
  for (int d0 = 0; d0 < 4; ++d0) { int cb = (map * 64 + d0 * 16 + hi * 8) * 2;
    bf16x8 b0 = *reinterpret_cast<const bf16x8*>((const char*)Ks + KSWZ(r32, cb));
    bf16x8 b1 = *reinterpret_cast<const bf16x8*>((const char*)Ks + KSWZ(32 + r32, cb));
    p0 = __builtin_amdgcn_mfma_f32_32x32x16_bf16(b0, qr[d0], p0, 0, 0, 0);
    p1 = __builtin_amdgcn_mfma_f32_32x32x16_bf16(b1, qr[d0], p1, 0, 0, 0); }
}
__device__ __forceinline__ int v_st(int k, int c) { const int kk = (k & ~0xC) | ((k & 4) << 1) | ((k & 8) >> 1); return ((kk >> 3) * 4 + (c >> 5)) * 512 + ((kk & 7) * 32 + (c & 31)) * 2; }
__device__ __forceinline__ int v_rd_base(int lane) { return ((lane & 3) << 3) | (((lane >> 2) & 3) << 6) | (((lane >> 4) & 1) << 5) | (((lane >> 5) & 1) << 8); }
constexpr int v_rd_off(int d0, int ks, int half) { return d0 * 512 + ks * 4096 + half * 2048; }
template <int OFF> __device__ __forceinline__ s16x4 tr_read(int vb) {
  s16x4 r; asm volatile("ds_read_b64_tr_b16 %0, %1 offset:%2" : "=&v"(r) : "v"(vb), "i"(OFF) : "memory"); return r;
}
template <int D0> __device__ __forceinline__ void pv_one(f32x16& od, int vb, bf16x8 pa0, bf16x8 pa1, bf16x8 pa2, bf16x8 pa3) {
  const s16x4 l0 = tr_read<v_rd_off(D0, 0, 0)>(vb), h0 = tr_read<v_rd_off(D0, 0, 1)>(vb), l1 = tr_read<v_rd_off(D0, 1, 0)>(vb), h1 = tr_read<v_rd_off(D0, 1, 1)>(vb);
  const s16x4 l2 = tr_read<v_rd_off(D0, 2, 0)>(vb), h2 = tr_read<v_rd_off(D0, 2, 1)>(vb), l3 = tr_read<v_rd_off(D0, 3, 0)>(vb), h3 = tr_read<v_rd_off(D0, 3, 1)>(vb);
  asm volatile("s_waitcnt lgkmcnt(0)" ::: "memory"); SBAR();
#define PK(L, H) (bf16x8){L[0], L[1], L[2], L[3], H[0], H[1], H[2], H[3]}
  od = __builtin_amdgcn_mfma_f32_32x32x16_bf16(pa0, PK(l0, h0), od, 0, 0, 0);
  od = __builtin_amdgcn_mfma_f32_32x32x16_bf16(pa1, PK(l1, h1), od, 0, 0, 0);
  od = __builtin_amdgcn_mfma_f32_32x32x16_bf16(pa2, PK(l2, h2), od, 0, 0, 0);
  od = __builtin_amdgcn_mfma_f32_32x32x16_bf16(pa3, PK(l3, h3), od, 0, 0, 0);
#undef PK
}
__device__ __forceinline__ void pv_d0(f32x16* o, int vb, bf16x8 pa0, bf16x8 pa1, bf16x8 pa2, bf16x8 pa3) {
  pv_one<0>(o[0], vb, pa0, pa1, pa2, pa3); pv_one<1>(o[1], vb, pa0, pa1, pa2, pa3); pv_one<2>(o[2], vb, pa0, pa1, pa2, pa3); pv_one<3>(o[3], vb, pa0, pa1, pa2, pa3);
}

__device__ __forceinline__ void attn_unit(const bf16* Qh, const bf16* Kc, const bf16* Vc, const bf16* Ko, const bf16* Vo, int nctx, int NT,
                                          bf16* Out, const float* sg, float lam, float osc, char* lds) {
  int tid_l = threadIdx.x; asm volatile("" : "+v"(tid_l));
  const int tid = tid_l, wid = tid >> 6, lane = tid & 63, r32 = lane & 31, hi = lane >> 5, map = wid & 1, pair = wid >> 1;
  bf16* V_lds = (bf16*)lds; bf16* K_lds = (bf16*)(lds + 2 * SHM_V);
  float* ws = (float*)(lds + 2 * SHM_V + 2 * SHM_K) + wid * 64; float* li_l = ws; float* al_l = ws + 32;
  float m_reg = -1e30f, l_reg = 0; f32x16 o[4] = {}; bf16x8 qr[4];
  const bf16* Qw = Qh + (long)(pair * QBLK + r32) * LDK + map * 64 + hi * 8;
#pragma unroll
  for (int d0 = 0; d0 < 4; ++d0) qr[d0] = ld8(Qw + d0 * 16);
  const int sr = tid >> 4, sc = (tid & 15) * 8, vst0 = v_st(sr, sc), vst1 = v_st(32 + sr, sc);
  const int vb0 = (int)(uintptr_t)V_lds + v_rd_base(lane);
  struct { bf16x8 vs0, vs1, ks0, ks1; } sr_[2];
#define KT(t) (((t) < nctx) ? (Kc + (long)(t) * (KVBLK * LDK)) : (Ko + (long)((t) - nctx) * (KVBLK * LDK)))
#define VT(t) (((t) < nctx) ? (Vc + (long)(t) * (KVBLK * LDK)) : (Vo + (long)((t) - nctx) * (KVBLK * LDK)))
#define SLOAD(i, t) do { const bf16* kt_ = KT(t); const bf16* vt_ = VT(t); sr_[i].vs0 = ld8(&vt_[(long)(sr) * LDK + sc]); sr_[i].vs1 = ld8(&vt_[(long)(32 + sr) * LDK + sc]); \
    sr_[i].ks0 = ld8(&kt_[(long)(sr) * LDK + sc]); sr_[i].ks1 = ld8(&kt_[(long)(32 + sr) * LDK + sc]); } while (0)
#define SWRITE(b, i) do { *(bf16x8*)((char*)V_lds + (b) * SHM_V + vst0) = sr_[i].vs0;          \
    *(bf16x8*)((char*)V_lds + (b) * SHM_V + vst1) = sr_[i].vs1; int kc = sc * 2;               \
    *(bf16x8*)((char*)K_lds + (b) * SHM_K + KSWZ(sr, kc)) = sr_[i].ks0;                       \
    *(bf16x8*)((char*)K_lds + (b) * SHM_K + KSWZ(32 + sr, kc)) = sr_[i].ks1; } while (0)
#define SWAIT() asm volatile("s_waitcnt vmcnt(4)" ::: "memory")
#define RESC(a) do { } while (0)
  f32x16 pA0, pA1, pB0, pB1; float mnA, mnB, alA, alB; bf16x8 pa0, pa1, pa2, pa3;
  constexpr int SE = 0, SO = 1;
  SLOAD(SE, 0); asm volatile("s_waitcnt vmcnt(0)" ::: "memory"); SWRITE(0, SE); __syncthreads();
  qkt(pA0, pA1, K_lds, qr, r32, hi, map); partialSM(pA0, pA1, m_reg, mnA, alA);
  SLOAD(SO, 1); if (2 < NT) SLOAD(SE, 2);
  SWAIT(); SWRITE(1, SO); __syncthreads();
  for (int j = 1; j + 1 < NT; j += 2) {
    SBAR(); qkt(pB0, pB1, (bf16*)((char*)K_lds + SHM_K), qr, r32, hi, map);
    finishSM(pA0, pA1, alA, l_reg, pa0, pa1, pa2, pa3); SBAR();
    SLOAD(SO, j + 2); SBAR();
    pv_d0(o, vb0, pa0, pa1, pa2, pa3); partialSM(pB0, pB1, m_reg, mnB, alB);
    __syncthreads(); SWAIT(); SWRITE(0, SE);
    RESC(alB); __syncthreads();
    SBAR(); qkt(pA0, pA1, K_lds, qr, r32, hi, map);
    finishSM(pB0, pB1, alB, l_reg, pa0, pa1, pa2, pa3); SBAR();
    if (j + 3 < NT) SLOAD(SE, j + 3); SBAR();
    pv_d0(o, vb0 + (int)SHM_V, pa0, pa1, pa2, pa3); partialSM(pA0, pA1, m_reg, mnA, alA);
    __syncthreads(); SWAIT(); SWRITE(1, SO);
    RESC(alA); __syncthreads();
  }
  SBAR(); qkt(pB0, pB1, (bf16*)((char*)K_lds + SHM_K), qr, r32, hi, map);
  finishSM(pA0, pA1, alA, l_reg, pa0, pa1, pa2, pa3); SBAR();
  pv_d0(o, vb0, pa0, pa1, pa2, pa3); partialSM(pB0, pB1, m_reg, mnB, alB);
  __syncthreads(); RESC(alB);
  finishSM(pB0, pB1, alB, l_reg, pa0, pa1, pa2, pa3); SBAR();
  pv_d0(o, vb0 + (int)SHM_V, pa0, pa1, pa2, pa3);
  if (hi == 0) li_l[r32] = l_reg; asm volatile("s_waitcnt lgkmcnt(0)" ::: "memory");
  float rli[16];
#pragma unroll
  for (int r = 0; r < 16; ++r) rli[r] = __builtin_amdgcn_rcpf(li_l[crow(r, hi)]);
#pragma unroll
  for (int d0 = 0; d0 < 4; ++d0)
#pragma unroll
    for (int r = 0; r < 16; ++r) o[d0][r] *= rli[r];
  __syncthreads();
  float* xch = (float*)lds + pair * 4096;
  if (map == 1) {
#pragma unroll
    for (int d0 = 0; d0 < 4; ++d0)
#pragma unroll
      for (int r = 0; r < 16; ++r) xch[(r * 4 + d0) * 64 + lane] = o[d0][r];
  }
  __syncthreads();
  if (map == 0) {
    float gsub[4];
#pragma unroll
    for (int d0 = 0; d0 < 4; ++d0) gsub[d0] = sg[d0 * 32 + r32] * osc;
#pragma unroll
    for (int r = 0; r < 16; ++r) {
      float ss = 0.f;
#pragma unroll
      for (int d0 = 0; d0 < 4; ++d0) { const float v = o[d0][r] - lam * xch[(r * 4 + d0) * 64 + lane]; o[d0][r] = v; ss += v * v; }
      ss += __shfl_xor(ss, 1); ss += __shfl_xor(ss, 2); ss += __shfl_xor(ss, 4); ss += __shfl_xor(ss, 8); ss += __shfl_xor(ss, 16);
      const float rstd = __builtin_amdgcn_rsqf(ss * (1.0f / 128.0f) + 1e-6f);
      bf16* orow = Out + (long)(pair * QBLK + crow(r, hi)) * LDK + r32;
#pragma unroll
      for (int d0 = 0; d0 < 4; ++d0) orow[d0 * 32] = (bf16)(cvtpk(o[d0][r] * rstd * gsub[d0], 0.f) & 0xffffu);
    }
  }
  __syncthreads();
#undef KT
#undef VT
#undef SLOAD
#undef SWRITE
#undef SWAIT
#undef RESC
}
#undef KSWZ
#undef SBAR
}
#define LAS __attribute__((address_space(3)))
typedef unsigned short bf16;
typedef float f32x4 __attribute__((ext_vector_type(4)));
typedef unsigned v4u __attribute__((ext_vector_type(4)));
typedef unsigned v2u __attribute__((ext_vector_type(2)));
constexpr int NWAVES = 8, NTHR = 512;
constexpr int T = 20480, TPR = 4096, D = 1024, FF = 2816;
constexpr size_t MiB = 1u << 20;
constexpr size_t WS_MOD = 1 * MiB;
constexpr size_t WS_W13T = 2 * MiB;
constexpr size_t WS_W2T = 24 * MiB;
constexpr size_t WS_WINT = 35 * MiB;
constexpr size_t WS_WGT = 43 * MiB;
constexpr size_t WS_WPAT = 49 * MiB, WS_WOUTT = 51 * MiB, WS_WPPT = 53 * MiB, WS_WFT = 54 * MiB;
constexpr size_t WS_CS2048 = 56 * MiB;
constexpr size_t WS_CS256 = 72 * MiB;
constexpr size_t WS_CK = 73 * MiB, WS_CV = 81 * MiB;
constexpr size_t WS_X = 89 * MiB;
constexpr size_t WS_H = 169 * MiB;
constexpr size_t WS_R = 209 * MiB;
constexpr size_t WS_Q = WS_R, WS_V = WS_R + 40 * MiB, WS_K = WS_R + 80 * MiB, WS_UP = WS_R + 140 * MiB, WS_UT = WS_R + 160 * MiB;
constexpr size_t WS_HID = WS_R;
constexpr size_t WS_DP = WS_K;
constexpr size_t WS_Z = WS_V;
constexpr size_t WS_MB = WS_K + 20 * MiB;
constexpr size_t WS_G = WS_UP;
constexpr size_t WS_END = WS_R + 180 * MiB;
constexpr int LDS_BYTES = 147456;

struct Args { const float* in[23]; float* out; unsigned char* ws; int ph_lo, ph_hi; };
enum { I_XP = 0, I_XS, I_CK, I_CV, I_C, I_CCTX, I_WADA, I_BADA, I_NORMG, I_W13, I_W2, I_WIN, I_QG, I_KG, I_LAMQK, I_SUBG, I_WPOOL, I_PSCALE, I_WGATE, I_WPA, I_WPP, I_WPF, I_WOUT };

__device__ __forceinline__ unsigned f2bf(float f) { unsigned u = __builtin_bit_cast(unsigned, f); return (u + 0x7fffu + ((u >> 16) & 1u)) >> 16; }
__device__ __forceinline__ unsigned pk2(float lo, float hi) { return f2bf(lo) | (f2bf(hi) << 16); }
__device__ __forceinline__ float wave_sum(float v) {
#pragma unroll
    for (int o = 1; o < 64; o <<= 1) v += __shfl_xor(v, o);
    return v;
}
__device__ __forceinline__ int rowmap(int kind, int L) {
    if (kind == 1) { const int up = L >= FF ? 1 : 0, hc = L - up * FF; return (hc >> 7) * 256 + up * 128 + (hc & 127); }
    if (kind == 2 && L < 2048) { const int pn = L >> 8, r = L & 255, wc = r >> 6, bj = (r >> 5) & 1, n = (r >> 4) & 1, fq = (r >> 2) & 3, j = r & 3; return pn * 256 + bj * 128 + wc * 32 + fq * 8 + n * 4 + j; }
    return L;
}
__device__ __forceinline__ void transpose_item(const float* W, int K, int N, bf16* WT, int kind, LAS float* scr, int item, int lane) {
    const int nblk = N / 32, kb = item / nblk, nb = item % nblk, k0 = 64 * kb, n0 = 32 * nb;
#pragma unroll 8
    for (int i = 0; i < 32; ++i) { const int kk = 2 * i + (lane >> 5); scr[kk * 33 + (lane & 31)] = __builtin_nontemporal_load(W + (size_t)(k0 + kk) * N + n0 + (lane & 31)); }
    asm volatile("s_waitcnt lgkmcnt(0)" ::: "memory");
    const int c = lane & 7;
#pragma unroll
    for (int j = 0; j < 4; ++j) { const int n = (lane >> 3) + 8 * j; const LAS float* s = scr + (8 * c) * 33 + n;
        v4u o; o.x = pk2(s[0 * 33], s[1 * 33]); o.y = pk2(s[2 * 33], s[3 * 33]); o.z = pk2(s[4 * 33], s[5 * 33]); o.w = pk2(s[6 * 33], s[7 * 33]);
        *(v4u*)(WT + (size_t)rowmap(kind, n0 + n) * K + k0 + 8 * c) = o; }
    asm volatile("s_waitcnt lgkmcnt(0)" ::: "memory");
}

__device__ __forceinline__ void adaln_phase(const Args& a, LAS unsigned char* lds, int tid) {
    LAS float* sc = (LAS float*)lds;
    LAS float* red = (LAS float*)(lds + 9 * 1024 * 4);
    for (int i = tid; i < 9 * 1024; i += NTHR) { const float v = i < 8192 ? a.in[I_C][i] : a.in[I_CCTX][i - 8192]; sc[i] = v * sigmoidf_(v); }
    __syncthreads();
    float* MOD = (float*)(a.ws + WS_MOD);
    const int col = tid & 31, ks = tid >> 5;
    for (int it = blockIdx.x; it < 2 * 288; it += gridDim.x) {
        const int l = it / 288, n0 = (it % 288) * 32;
        const float* W = a.in[I_WADA] + (size_t)l * 1024 * 9216 + n0 + col;
        float acc[9];
#pragma unroll
        for (int c = 0; c < 9; ++c) acc[c] = 0.f;
#pragma unroll 4
        for (int k = ks * 64; k < ks * 64 + 64; ++k) { const float w = __builtin_nontemporal_load(W + (size_t)k * 9216);
#pragma unroll
            for (int c = 0; c < 9; ++c) acc[c] += sc[c * 1024 + k] * w; }
#pragma unroll
        for (int c = 0; c < 9; ++c) red[(ks * 9 + c) * 32 + col] = acc[c];
        __syncthreads();
        if (tid < 288) { const int c = tid >> 5; float s = a.in[I_BADA][l * 9216 + n0 + col];
#pragma unroll
            for (int q = 0; q < 16; ++q) s += red[(q * 9 + c) * 32 + col];
            MOD[((size_t)l * 9 + c) * 9216 + n0 + col] = s; }
        __syncthreads();
    }
}
__device__ __forceinline__ void prep_layer(const Args& a, int l, LAS unsigned char* lds, int gw, int NGW, int wave, int lane) {
    LAS float* scr = (LAS float*)(lds + wave * 16384);
    unsigned char* ws = a.ws;
    constexpr int I13 = (D / 64) * (2 * FF / 32), I2 = (FF / 64) * (D / 32), IIN = (D / 64) * (4096 / 32), IG = (D / 64) * (3072 / 32), ISQ = (D / 64) * (D / 32);
    constexpr int NIT = 2 * I13 + 2 * I2 + IIN + IG + 2 * ISQ;
    for (int it = gw; it < NIT; it += NGW) {
        int r = it;
        if (r < 2 * I13) { const int s = r / I13; transpose_item(a.in[I_W13] + ((size_t)l * 2 + s) * D * 2 * FF, D, 2 * FF, (bf16*)(ws + WS_W13T) + (size_t)s * 2 * FF * D, 1, scr, r % I13, lane); continue; } r -= 2 * I13;
        if (r < 2 * I2) { const int s = r / I2; transpose_item(a.in[I_W2] + ((size_t)l * 2 + s) * FF * D, FF, D, (bf16*)(ws + WS_W2T) + (size_t)s * D * FF, 0, scr, r % I2, lane); continue; } r -= 2 * I2;
        if (r < IIN) { transpose_item(a.in[I_WIN] + (size_t)l * D * 4096, D, 4096, (bf16*)(ws + WS_WINT), 2, scr, r, lane); continue; } r -= IIN;
        if (r < IG) { transpose_item(a.in[I_WGATE] + (size_t)l * D * 3072, D, 3072, (bf16*)(ws + WS_WGT), 0, scr, r, lane); continue; } r -= IG;
        if (r < ISQ) { transpose_item(a.in[I_WPA] + (size_t)l * D * D, D, D, (bf16*)(ws + WS_WPAT), 0, scr, r, lane); continue; } r -= ISQ;
        transpose_item(a.in[I_WOUT] + (size_t)l * D * D, D, D, (bf16*)(ws + WS_WOUTT), 0, scr, r, lane);
    }
    {
        const float* wpool = a.in[I_WPOOL] + (size_t)l * 4 * 128 * 128; const float* psc = a.in[I_PSCALE] + (size_t)l * 512; const float* wpp = a.in[I_WPP] + (size_t)l * 512 * D;
        bf16* WPPT = (bf16*)(ws + WS_WPPT);
        for (int it = gw; it < 16 * 64; it += NGW) {
            const int n = (it & 15) * 64 + lane, kc = it >> 4, g = kc >> 4, c0 = (kc & 15) * 8;
            float acc[8];
#pragma unroll
            for (int j = 0; j < 8; ++j) acc[j] = 0.f;
            for (int cp = 0; cp < 128; ++cp) { const float w = wpp[(size_t)(g * 128 + cp) * D + n] * psc[g * 128 + cp];
#pragma unroll
                for (int j = 0; j < 8; ++j) acc[j] += wpool[(g * 128 + c0 + j) * 128 + cp] * w; }
            v4u o; o.x = pk2(acc[0], acc[1]); o.y = pk2(acc[2], acc[3]); o.z = pk2(acc[4], acc[5]); o.w = pk2(acc[6], acc[7]);
            *(v4u*)(WPPT + (size_t)n * 512 + kc * 8) = o;
        }
        const float* wpf = a.in[I_WPF] + (size_t)l * 512 * D; bf16* WFT = (bf16*)(ws + WS_WFT);
        for (int it = gw; it < 16 * 128; it += NGW) {
            const int n = (it & 15) * 64 + lane, kc = it >> 4, which = kc >> 6, g = (kc >> 4) & 3, c0 = (kc & 15) * 8;
#pragma unroll
            for (int i = 0; i < 16; ++i) { const int e = lane + 64 * i, cp = e >> 3, j = e & 7; const float rv = (float)(((c0 + j) * cp) & 127) * (1.0f / 128.0f);
                scr[e] = which ? -__builtin_amdgcn_sinf(rv) : __builtin_amdgcn_cosf(rv); }
            asm volatile("s_waitcnt lgkmcnt(0)" ::: "memory");
            float acc[8];
#pragma unroll
            for (int j = 0; j < 8; ++j) acc[j] = 0.f;
#pragma unroll 4
            for (int cp = 0; cp < 128; ++cp) { const float w = wpf[(size_t)(g * 128 + cp) * D + n];
                const f32x4 t0 = *(const LAS f32x4*)(scr + cp * 8), t1 = *(const LAS f32x4*)(scr + cp * 8 + 4);
                acc[0] += t0[0] * w; acc[1] += t0[1] * w; acc[2] += t0[2] * w; acc[3] += t0[3] * w; acc[4] += t1[0] * w; acc[5] += t1[1] * w; acc[6] += t1[2] * w; acc[7] += t1[3] * w; }
            asm volatile("s_waitcnt lgkmcnt(0)" ::: "memory");
            const float sc_ = 0.08838834764831845f;
            v4u o; o.x = pk2(acc[0] * sc_, acc[1] * sc_); o.y = pk2(acc[2] * sc_, acc[3] * sc_); o.z = pk2(acc[4] * sc_, acc[5] * sc_); o.w = pk2(acc[6] * sc_, acc[7] * sc_);
            *(v4u*)(WFT + (size_t)n * 1024 + kc * 8) = o;
        }
    }
    {
        const int gt = gw * 64 + lane, NGT = NGW * 64;
        for (int i = gt; i < 2 * 524288; i += NGT) {
            const int which = i >= 524288, j = which ? i - 524288 : i, b = j >> 16, rem = j & 65535;
            const float* src = a.in[which ? I_CV : I_CK] + ((size_t)(b * 2 + l) * 512 * 1024) + (size_t)rem * 8;
            const f32x4 x0 = __builtin_nontemporal_load((const f32x4*)src), x1 = __builtin_nontemporal_load((const f32x4*)(src + 4));
            v4u o; o.x = pk2(x0[0], x0[1]); o.y = pk2(x0[2], x0[3]); o.z = pk2(x1[0], x1[1]); o.w = pk2(x1[2], x1[3]);
            *(v4u*)((bf16*)(ws + (which ? WS_CV : WS_CK)) + (size_t)j * 8) = o;
        }
    }
}
__device__ __forceinline__ void dft_matrices(const Args& a, int gt, int NGT) {
    for (int pass = 0; pass < 2; ++pass) {
        const int L = pass ? 256 : 2048, lg = pass ? 8 : 11; bf16* CS = (bf16*)(a.ws + (pass ? WS_CS256 : WS_CS2048));
        const float scl = pass ? 0.0625f : 0.022097086912079608f, invL = 1.0f / (float)L;
        const int nitem = 2 * L * L / 8;
        for (int i = gt; i < nitem; i += NGT) {
            const int r = i >> (lg - 3), l0 = (i & ((L >> 3) - 1)) * 8, which = r >> lg, lp = r & (L - 1);
            float v[8];
#pragma unroll
            for (int j = 0; j < 8; ++j) { const float rv = (float)((lp * (l0 + j)) & (L - 1)) * invL; v[j] = (which ? __builtin_amdgcn_sinf(rv) : __builtin_amdgcn_cosf(rv)) * scl; }
            v4u o; o.x = pk2(v[0], v[1]); o.y = pk2(v[2], v[3]); o.z = pk2(v[4], v[5]); o.w = pk2(v[6], v[7]);
            *(v4u*)(CS + (size_t)r * L + l0) = o;
        }
    }
}
__device__ __forceinline__ void rows_phase(const Args& a, int l, int sub, bool from_input, int gw, int NGW, int lane, const bf16* DL = nullptr) {
    const float* MOD = (const float*)(a.ws + WS_MOD) + (size_t)l * 9 * 9216;
    const float* ng = a.in[I_NORMG] + ((size_t)l * 3 + sub) * D;
    float* X = (float*)(a.ws + WS_X); bf16* H = (bf16*)(a.ws + WS_H);
    f32x4 g4[4];
#pragma unroll
    for (int j = 0; j < 4; ++j) g4[j] = *(const f32x4*)(ng + 4 * lane + 256 * j);
#define ROWPTR(m_) (from_input ? ((m_) < TPR ? a.in[I_XP] + (size_t)(m_) * D : a.in[I_XS] + (size_t)((m_) - TPR) * D) : X + (size_t)(m_) * D)
    f32x4 v[4], vn[4]; v2u dn[4];
    if (gw < T) { const float* xr = ROWPTR(gw);
#pragma unroll
        for (int j = 0; j < 4; ++j) { vn[j] = __builtin_nontemporal_load((const f32x4*)(xr + 4 * lane + 256 * j)); if (DL) dn[j] = __builtin_nontemporal_load((const v2u*)(DL + (size_t)gw * D + 4 * lane + 256 * j)); } }
    for (int m = gw; m < T; m += NGW) {
        const int cb = m < TPR ? 8 : ((m - TPR) >> 11);
        const float* sh = MOD + (size_t)cb * 9216 + (3 * sub) * D; const float* scp = sh + D;
        float s = 0.f;
#pragma unroll
        for (int j = 0; j < 4; ++j) { v[j] = vn[j]; if (DL) v[j] += (f32x4){bf_lo(dn[j].x), bf_hi(dn[j].x), bf_lo(dn[j].y), bf_hi(dn[j].y)};
            s += (v[j][0] * v[j][0] + v[j][1] * v[j][1]) + (v[j][2] * v[j][2] + v[j][3] * v[j][3]); }
        if (m + NGW < T) { const float* xr = ROWPTR(m + NGW);
#pragma unroll
            for (int j = 0; j < 4; ++j) { vn[j] = __builtin_nontemporal_load((const f32x4*)(xr + 4 * lane + 256 * j)); if (DL) dn[j] = __builtin_nontemporal_load((const v2u*)(DL + (size_t)(m + NGW) * D + 4 * lane + 256 * j)); } }
        if (DL) {
#pragma unroll
            for (int j = 0; j < 4; ++j) __builtin_nontemporal_store(v[j], (f32x4*)(X + (size_t)m * D + 4 * lane + 256 * j));
        }
        const float rstd = 1.0f / sqrtf(wave_sum(s) * (1.0f / D) + 1e-6f);
#pragma unroll
        for (int j = 0; j < 4; ++j) { const f32x4 sc4 = *(const f32x4*)(scp + 4 * lane + 256 * j), sh4 = *(const f32x4*)(sh + 4 * lane + 256 * j);
            const f32x4 y = v[j] * rstd * g4[j] * (sc4 + 1.0f) + sh4;
            v2u o; o.x = pk2(y[0], y[1]); o.y = pk2(y[2], y[3]);
            *(v2u*)(H + (size_t)m * D + 4 * lane + 256 * j) = o; }
    }
#undef ROWPTR
}
__device__ __forceinline__ void pool_phase(const Args& a, int gt, int NGT) {
    const bf16* UP = (const bf16*)(a.ws + WS_UP); bf16* DP = (bf16*)(a.ws + WS_DP);
    for (int i = gt; i < T * 64; i += NGT) {
        const int tok = i >> 6, ch = (i & 63) * 8, g = ch >> 7, half = 1 << g;
        int s0, L, s;
        if (tok < TPR) { L = 256; s0 = tok & ~255; s = tok & 255; } else { L = 2048; s0 = TPR + ((tok - TPR) & ~2047); s = (tok - TPR) & 2047; }
        const int lo = s - half < 0 ? 0 : s - half, hi = s + half > L ? L : s + half;
        float acc[8];
#pragma unroll
        for (int j = 0; j < 8; ++j) acc[j] = 0.f;
#pragma unroll
        for (int kb = 0; kb < 16; kb += 8) {
            v4u wv[8];
#pragma unroll
            for (int k = 0; k < 8; ++k) { int p = s - half + kb + k; p = p < lo ? lo : (p >= hi ? hi - 1 : p); wv[k] = *(const v4u*)(UP + (size_t)(s0 + p) * 512 + ch); }
#pragma unroll
            for (int k = 0; k < 8; ++k) { const int p = s - half + kb + k; const float m = (kb + k < 2 * half && p >= lo && p < hi) ? 1.0f : 0.0f; const v4u w = wv[k];
                acc[0] += m * bf_lo(w.x); acc[1] += m * bf_hi(w.x); acc[2] += m * bf_lo(w.y); acc[3] += m * bf_hi(w.y); acc[4] += m * bf_lo(w.z); acc[5] += m * bf_hi(w.z); acc[6] += m * bf_lo(w.w); acc[7] += m * bf_hi(w.w); }
            asm volatile("" ::: "memory");
        }
        const v4u w = *(const v4u*)(UP + (size_t)tok * 512 + ch); const float inv = 1.0f / (float)(hi - lo);
        v4u o; o.x = pk2(acc[0] * inv - bf_lo(w.x), acc[1] * inv - bf_hi(w.x)); o.y = pk2(acc[2] * inv - bf_lo(w.y), acc[3] * inv - bf_hi(w.y));
        o.z = pk2(acc[4] * inv - bf_lo(w.z), acc[5] * inv - bf_hi(w.z)); o.w = pk2(acc[6] * inv - bf_lo(w.w), acc[7] * inv - bf_hi(w.w));
        *(v4u*)(DP + (size_t)tok * 512 + ch) = o;
    }
}
__device__ __forceinline__ void attention_phase(const Args& a, int l, unsigned char* lds, int vcu, int G, bool dummy) {
    const att::bf16* Qb = (const att::bf16*)(a.ws + WS_Q); const att::bf16* Kb = (const att::bf16*)(a.ws + WS_K); const att::bf16* Vb = (const att::bf16*)(a.ws + WS_V);
    const att::bf16* CK = (const att::bf16*)(a.ws + WS_CK); const att::bf16* CV = (const att::bf16*)(a.ws + WS_CV);
    const float* lq = a.in[I_LAMQK] + (size_t)l * 256;
    float d1 = 0.f, d2 = 0.f;
    for (int i = 0; i < 64; ++i) { d1 += lq[i] * lq[64 + i]; d2 += lq[128 + i] * lq[192 + i]; }
    const float lam_init = l == 0 ? 0.2f : 0.35550906759f;
    const float lam = __expf(d1) - __expf(d2) + lam_init, osc = 1.0f - lam_init;
    const float* sg = a.in[I_SUBG] + (size_t)l * 128;
    for (int uidx = vcu; uidx < 1024 + 256; uidx += G) {
        int tok0, qb, h, nctx, NT; const att::bf16 *kc, *vc;
        if (uidx < 1024) { const int b = uidx >> 7; h = (uidx >> 4) & 7; qb = uidx & 15; tok0 = TPR + b * 2048; nctx = 8; NT = 40; kc = CK + (size_t)b * 512 * 1024; vc = CV + (size_t)b * 512 * 1024; }
        else { const int v = uidx - 1024, b = v >> 4; h = (v >> 1) & 7; qb = v & 1; tok0 = b * 256; nctx = 0; NT = 4; kc = CK; vc = CV; }
        const size_t hoff = (size_t)h * 128;
        att::attn_unit(Qb + (size_t)(tok0 + qb * 128) * 1024 + hoff, kc + hoff, vc + hoff, Kb + (size_t)tok0 * 1024 + hoff, Vb + (size_t)tok0 * 1024 + hoff, nctx, NT,
                       (dummy ? (att::bf16*)a.out : (att::bf16*)(a.ws + WS_Q)) + (size_t)(tok0 + qb * 128) * 1024 + hoff, sg, lam, osc, (char*)lds);
    }
}

#define XB_TMO      128
#define XB_XCNT(j)  (256  + 64 * (j))
#define XB_XSUB(j)  (1280 + 64 * (j))
#define XB_XGEN(j)  (2304 + 64 * (j))
#define XB_TOP      3328
#define XB_TOPGEN   3392
#define XCD_BAR_WORDS 3456
#define XB_SPIN_CAP (1u << 18)

__device__ __forceinline__ unsigned xb_ld(unsigned* p)              { return __hip_atomic_load(p, __ATOMIC_RELAXED, __HIP_MEMORY_SCOPE_AGENT); }
__device__ __forceinline__ unsigned xb_add(unsigned* p, unsigned v) { return __hip_atomic_fetch_add(p, v, __ATOMIC_RELAXED, __HIP_MEMORY_SCOPE_AGENT); }
__device__ __forceinline__ unsigned xb_xcc_id() { return (unsigned)__builtin_amdgcn_s_getreg((3 << 11) | 20) & 0xFu; }
#define XB_SPIN(cond, bar) do { unsigned _sp = 0; while (cond) { __builtin_amdgcn_s_sleep(1); \
    if ((++_sp & 255u) == 0u) { if (xb_ld(&(bar)[XB_TMO])) break; if (_sp > XB_SPIN_CAP) { atomicAdd(&(bar)[XB_TMO], 1u); break; } } } } while (0)

struct XcdBarrier {
    unsigned* bar; unsigned x;
    volatile LAS unsigned* st;
};

__device__ __forceinline__ XcdBarrier xcd_barrier_post(unsigned* bar, volatile LAS unsigned* st) {
    XcdBarrier b; b.bar = bar; b.x = xb_xcc_id(); b.st = st;
    if (threadIdx.x == 0) (void)xb_add(&bar[XB_XCNT(b.x)], 1u);
    return b;
}
__device__ __forceinline__ void xcd_barrier_complete(unsigned* bar, unsigned x, unsigned& nloc, unsigned& nx) {
    const unsigned G = gridDim.x * gridDim.y * gridDim.z;
    unsigned sum, cnt, mine, sp = 0u;
    for (;;) {
        sum = 0u; cnt = 0u; mine = 0u;
#pragma unroll
        for (unsigned j = 0; j < 16; ++j) { const unsigned c = xb_ld(&bar[XB_XCNT(j)]); sum += c; cnt += (c > 0u) ? 1u : 0u; mine = (j == x) ? c : mine; }
        if (sum == G) break;
        __builtin_amdgcn_s_sleep(1);
        if ((++sp & 255u) == 0u) { if (xb_ld(&bar[XB_TMO])) break; if (sp > XB_SPIN_CAP) { atomicAdd(&bar[XB_TMO], 1u); break; } }
    }
    nloc = mine > 0u ? mine : 1u; nx = cnt > 0u ? cnt : 1u;
}

__device__ __forceinline__ void xcd_barrier(const XcdBarrier& b) {
    asm volatile("s_waitcnt vmcnt(0)" ::: "memory");
    __syncthreads();
    if (threadIdx.x == 0) {
        unsigned* bar = b.bar;
        __builtin_amdgcn_s_waitcnt(0);
        unsigned nloc = b.st[0], nx = b.st[1];
        if (nloc == 0u) { xcd_barrier_complete(bar, b.x, nloc, nx); b.st[0] = nloc; b.st[1] = nx; }
        const unsigned old = xb_add(&bar[XB_XSUB(b.x)], 1u);
        const unsigned gen = old / nloc;
        if (old + 1u == (gen + 1u) * nloc) {
            __builtin_amdgcn_fence(__ATOMIC_RELEASE, "agent");
            asm volatile("s_waitcnt vmcnt(0)" ::: "memory");
            const unsigned og = xb_add(&bar[XB_TOP], 1u);
            const unsigned tg = og / nx;
            if (og + 1u == (tg + 1u) * nx) xb_add(&bar[XB_TOPGEN], 1u);
            else XB_SPIN(xb_ld(&bar[XB_TOPGEN]) == tg, bar);
            __builtin_amdgcn_fence(__ATOMIC_ACQUIRE, "agent");
            xb_add(&bar[XB_XGEN(b.x)], 1u);
            asm volatile("s_waitcnt vmcnt(0)" ::: "memory");
        } else {
            XB_SPIN(xb_ld(&bar[XB_XGEN(b.x)]) == gen, bar);
            __builtin_amdgcn_fence(__ATOMIC_ACQUIRE, "agent");
            asm volatile("s_waitcnt vmcnt(0)" ::: "memory");
        }
    }
    __syncthreads();
}

#ifndef PHMASK
#define PHMASK 0xffff
#endif
#ifndef REP_PRO
#define REP_PRO 1
#endif
#ifndef REP_ATT
#define REP_ATT 1
#endif
#ifndef REP_ROWS
#define REP_ROWS 1
#endif
#ifndef REP_PE
#define REP_PE 1
#endif
#ifndef REP_PA
#define REP_PA 1
#endif
#define PHON(b) ((PHMASK >> (b)) & 1)
__global__ void __launch_bounds__(NTHR, 2) fwd_mega(Args a) {
    extern __shared__ __attribute__((aligned(16))) unsigned char lds_raw[];
    LAS unsigned char* lds = (LAS unsigned char*)lds_raw;
    cg::grid_group grid = cg::this_grid();
    volatile LAS unsigned* MISC = (volatile LAS unsigned*)(lds + 131072 + 320);
    if (threadIdx.x < 32) MISC[threadIdx.x] = 0u;
    __syncthreads();
    XcdBarrier xbar = xcd_barrier_post((unsigned*)a.ws + 4096, MISC + 8);
    const int G = gridDim.x, bx = blockIdx.x, vcu = (G % 8 == 0) ? (bx % 8) * (G / 8) + bx / 8 : bx;
    unsigned char* ws = a.ws;
    bf16* const H = (bf16*)(ws + WS_H); float* const X = (float*)(ws + WS_X);
    for (int ph = a.ph_lo; ph < a.ph_hi; ++ph) {
        int tid_l = threadIdx.x; asm volatile("" : "+v"(tid_l));
        const int tid = tid_l, lane = tid & 63, wave = __builtin_amdgcn_readfirstlane(tid >> 6);
        const int gw = vcu * NWAVES + wave, NGW = G * NWAVES, gt = gw * 64 + lane, NGT = NGW * 64;
        if (ph == 0 && PHON(0)) {
            for (int rep = 0; rep < REP_PRO; ++rep) {
            adaln_phase(a, lds, tid);
            dft_matrices(a, gt, NGT);
            prep_layer(a, 0, lds, gw, NGW, wave, lane); }
        } else if (ph == 1 && PHON(1)) {
            rows_phase(a, 0, 0, true, gw, NGW, lane);
        } else if (ph == 13 && PHON(1)) {
            rows_phase(a, 1, 0, false, gw, NGW, lane, (const bf16*)(ws + WS_UP));
            for (int rep = 0; rep < REP_PRO; ++rep) prep_layer(a, 1, lds, gw, NGW, wave, lane);
        } else {
            const int l = ph >= 14 ? 1 : 0, sp = ph - (l ? 14 : 2);
            const float* MOD = (const float*)(ws + WS_MOD) + (size_t)l * 9 * 9216;
            if ((sp == 0 || sp == 9) && PHON(2)) {
                const int s = sp == 0 ? 0 : 1;
                pg8::Gemm g{H, (const bf16*)(ws + WS_W13T) + (size_t)s * 2 * FF * D, T, 2 * FF, D}; pg8::StaticOrder S; S.init(T, 2 * FF, G, bx);
                pg8::EpiSwiglu E{(bf16*)(ws + WS_HID)};
                for (int rep = 0; rep < REP_PA; ++rep) pg8::gemm_phase<pg8::EpiSwiglu, pg8::StaticOrder, true, true>(lds, g, S, E);
            } else if ((sp == 1 || sp == 10) && PHON(3)) {
                const int s = sp == 1 ? 0 : 1; const bool last = (l == 1 && sp == 10);
                pg8::Gemm g{(const bf16*)(ws + WS_HID), (const bf16*)(ws + WS_W2T) + (size_t)s * D * FF, T, D, FF}; pg8::HalfOrder S; S.init(bx);
                if (last) { pg8::EpiResid E{X, a.out, MOD + 8 * D, 0.5f}; pg8::gemm_phase<pg8::EpiResid, pg8::HalfOrder, true, true>(lds, g, S, E); }
                else { pg8::EpiDelta E{(bf16*)(ws + WS_UP), MOD + (s == 0 ? 2 : 8) * D, 0.5f}; pg8::gemm_phase<pg8::EpiDelta, pg8::HalfOrder, true, true>(lds, g, S, E); }
            } else if ((sp == 2 || sp == 8) && PHON(1)) {
                rows_phase(a, l, sp == 2 ? 1 : 2, l == 0 && sp == 2, gw, NGW, lane, (const bf16*)(ws + WS_UP));
            } else if (sp == 3 && PHON(4)) {
                pg8::Gemm g{H, (const bf16*)(ws + WS_WINT), T, 4096, D}; pg8::StaticOrder S; S.init(T, 4096, G, bx);
                float* stk = a.out + (size_t)T * D + (size_t)l * 256 * D; float* stv = stk + (size_t)16 * 2 * 256 * D;
                pg8::EpiProj E{(bf16*)(ws + WS_Q), (bf16*)(ws + WS_K), (bf16*)(ws + WS_V), (bf16*)(ws + WS_UP), (bf16*)(ws + WS_UT), (bf16*)(ws + WS_UT) + (size_t)8 * 512 * 2048,
                               stk, stv, a.in[I_QG] + l * 64, a.in[I_KG] + l * 64};
                pg8::gemm_phase<pg8::EpiProj, pg8::StaticOrder, true, true>(lds, g, S, E);
            } else if (sp == 4 && PHON(5)) {
                for (int rep = REP_ATT - 1; rep >= 0; --rep) attention_phase(a, l, lds_raw, vcu, G, rep != 0);
            } else if (sp == 5 && PHON(6)) {
                pool_phase(a, gt, NGT);
                for (int kind = 0; kind < 2; ++kind) {
                    pg8::Gemm g; pg8::EpiFourier E; pg8::StaticOrder S;
                    if (kind == 0) { g = pg8::Gemm{(const bf16*)(ws + WS_CS2048), (const bf16*)(ws + WS_UT), 4096, 4096, 2048}; E = pg8::EpiFourier{(bf16*)(ws + WS_Z), 3, TPR, 2048}; }
                    else { g = pg8::Gemm{(const bf16*)(ws + WS_CS256), (const bf16*)(ws + WS_UT) + (size_t)8 * 512 * 2048, 512, 8192, 256}; E = pg8::EpiFourier{(bf16*)(ws + WS_Z), 0, 0, 256}; }
                    S.init(g.M, g.N, G, bx);
                    pg8::gemm_phase<pg8::EpiFourier, pg8::StaticOrder, true, true>(lds, g, S, E);
                }
            } else if (sp == 6 && PHON(7)) {
                for (int step6 = 0; step6 < 6 * REP_PE; ++step6) {
                    const int step = step6 % 6, br = step >> 1;
                    pg8::Gemm g; pg8::HalfOrder S; S.init(bx);
                    pg8::EpiMerge E{(bf16*)(ws + WS_G), (bf16*)a.out, (bf16*)(ws + WS_MB), 0};
                    if ((step & 1) == 0) g = pg8::Gemm{H, (const bf16*)(ws + WS_WGT) + (size_t)br * D * D, T, D, D};
                    else { E.mode = br + 1;
                        if (br == 0) g = pg8::Gemm{(const bf16*)(ws + WS_Q), (const bf16*)(ws + WS_WPAT), T, D, D};
                        else if (br == 1) g = pg8::Gemm{(const bf16*)(ws + WS_DP), (const bf16*)(ws + WS_WPPT), T, D, 512};
                        else g = pg8::Gemm{(const bf16*)(ws + WS_Z), (const bf16*)(ws + WS_WFT), T, D, D}; }
                    pg8::gemm_phase<pg8::EpiMerge, pg8::HalfOrder, true, true>(lds, g, S, E);
                }
            } else if (sp == 7 && PHON(8)) {
                pg8::Gemm g{(const bf16*)(ws + WS_MB), (const bf16*)(ws + WS_WOUTT), T, D, D}; pg8::HalfOrder S; S.init(bx);
                pg8::EpiDelta E{(bf16*)(ws + WS_UP), MOD + 5 * D, 1.0f};
                pg8::gemm_phase<pg8::EpiDelta, pg8::HalfOrder, true, true>(lds, g, S, E);
            }
        }
        if (ph + 1 < a.ph_hi) { if (a.ph_hi > 1000) grid.sync(); xcd_barrier(xbar); }
    }
}

constexpr int N_PHASES = 25;
#ifndef MK_ONE_LAUNCH
#define MK_ONE_LAUNCH 1
#endif
extern "C" void kernel_launch(void* const* d_in, const int* in_sizes, int n_in, void* d_out, int out_size, void* d_ws, size_t ws_size, hipStream_t stream) {
    static int grid = 0;
    if (grid == 0) {
        if (n_in != 23 || ws_size < WS_END) { fprintf(stderr, "kernel_launch: n_in %d ws %zu (need 23, >= %zu)\n", n_in, ws_size, (size_t)WS_END); grid = -1; return; }
        int dev = 0, cus = 0, per_cu = 0;
        hipGetDevice(&dev); hipDeviceGetAttribute(&cus, hipDeviceAttributeMultiprocessorCount, dev);
        if (hipFuncSetAttribute((const void*)fwd_mega, hipFuncAttributeMaxDynamicSharedMemorySize, LDS_BYTES) != hipSuccess) { fprintf(stderr, "kernel_launch: hipFuncSetAttribute failed\n"); grid = -1; return; }
        if (hipOccupancyMaxActiveBlocksPerMultiprocessor(&per_cu, (const void*)fwd_mega, NTHR, LDS_BYTES) != hipSuccess || per_cu < 1) { fprintf(stderr, "kernel_launch: occupancy query says %d\n", per_cu); per_cu = 1; }
        (void)hipGetLastError();
        if (cus != 256) { fprintf(stderr, "kernel_launch: built for a 256-CU device (got %d)\n", cus); grid = -1; return; }
        grid = cus * 1;
    }
    if (grid < 0) return;
    Args a{};
    for (int i = 0; i < 23; ++i) a.in[i] = (const float*)d_in[i];
    a.out = (float*)d_out; a.ws = (unsigned char*)d_ws;
#if MK_ONE_LAUNCH
    if (hipMemsetAsync(d_ws, 0, 65536, stream) != hipSuccess) { fprintf(stderr, "kernel_launch: memset failed\n"); return; }
    a.ph_lo = 0; a.ph_hi = N_PHASES;
    void* args[] = {&a};
    hipError_t e = hipLaunchCooperativeKernel((const void*)fwd_mega, dim3(grid), dim3(NTHR), args, LDS_BYTES, stream);
    if (e != hipSuccess) fprintf(stderr, "cooperative launch failed: %s (grid %d)\n", hipGetErrorString(e), grid);
#else
    for (int ph = 0; ph < N_PHASES; ++ph) {
        a.ph_lo = ph; a.ph_hi = ph + 1;
        hipLaunchKernelGGL(fwd_mega, dim3(grid), dim3(NTHR), LDS_BYTES, stream, a);
    }
#endif
}
```

```cpp
#include <hip/hip_runtime.h>
#include <hip/hip_bf16.h>
#include <hip/hip_cooperative_groups.h>
#include <cstdio>
#include <cstdint>
#include <cmath>
namespace cg = cooperative_groups;
namespace pg8 {
#define PG8_LAS __attribute__((address_space(3)))
typedef unsigned short bf16_t;
typedef short bf16x8 __attribute__((ext_vector_type(8)));
typedef float f32x4 __attribute__((ext_vector_type(4)));
typedef unsigned u32x4 __attribute__((ext_vector_type(4)));
constexpr int BM = 256, BK = 64, HALF = 128, HTB = HALF * BK * 2  , STAGE_BYTES = 8 * HTB, NXCD = 8, WGM = 8;

__host__ __device__ __forceinline__ int lds_byte(int r, int c) { const int st = (r >> 4) * 2 + (c >> 5), rr = r & 15, cc = c & 31, ob = rr * 64 + cc * 2; return st * 1024 + (ob ^ (((ob >> 9) & 1) << 5)); }
__host__ __device__ __forceinline__ void stage_rc(int b, int& R, int& C) { const int st = b / 1024, sb = b % 1024, swz = sb ^ (((sb >> 9) & 1) << 5); R = (st >> 1) * 16 + swz / 64; C = (st & 1) * 32 + (swz % 64) / 2; }
__host__ __device__ __forceinline__ int perm32(int rho) { const int n = rho >> 4, i = rho & 15; return 8 * (i >> 2) + 4 * n + (i & 3); }

struct Unit { int pm, pn, half, nhalf; };
struct Gemm { const bf16_t* A; const bf16_t* Bt; int M, N, K; };

struct StaticOrder {
    int nM, nN, nwg, G, c;
    __host__ __device__ void init(int M, int N, int G_, int c_) { nM = M / BM; nN = N / BM; nwg = nM * nN; G = G_; c = c_; }
    __host__ __device__ bool next(int i, Unit& u) const {
        const long L = (long)i * G + c; if (L >= nwg) return false;
        int wgid = (int)L; { const int q = nwg / NXCD, r = nwg % NXCD, xcd = wgid % NXCD, off = wgid / NXCD; wgid = (xcd < r ? xcd * (q + 1) : r * (q + 1) + (xcd - r) * q) + off; }
        const int nig = WGM * nN, gid = wgid / nig, fm = gid * WGM, gsz = (nM - fm) < WGM ? (nM - fm) : WGM;
        u.pm = fm + ((wgid % nig) % gsz); u.pn = (wgid % nig) / gsz; u.half = -1; u.nhalf = -1; return true;
    }
    __device__ __forceinline__ void a_ready(const Unit&) const {}
    __device__ __forceinline__ void done(const Unit&) const {}
};
struct HalfOrder {
    int c;
    __device__ void init(int c_) { c = c_; }
    __device__ bool next(int i, Unit& u) const {
        const int xcd = c & 7, idx = c >> 3, su = xcd * 8 + (idx >> 2), q = idx & 3;
        if (i == 0) { u.pm = su; u.pn = q; u.half = -1; u.nhalf = -1; return true; }
        if (i == 1) { u.pm = 64 + (su >> 2); u.pn = su & 3; u.half = q >> 1; u.nhalf = q & 1; return true; }
        return false;
    }
    __device__ __forceinline__ void a_ready(const Unit&) const {}
    __device__ __forceinline__ void done(const Unit&) const {}
};


constexpr int T_TOK = 20480, T_PR = 4096, DM = 1024, FFD = 2816;
typedef unsigned u32x2 __attribute__((ext_vector_type(2)));
__device__ __forceinline__ unsigned cvt_pk_bf16(float lo, float hi) { unsigned r; asm volatile("v_cvt_pk_bf16_f32 %0, %1, %2" : "=v"(r) : "v"(lo), "v"(hi)); return r; }
__device__ __forceinline__ float bf_lo(unsigned w) { return __uint_as_float(w << 16); }
__device__ __forceinline__ float bf_hi(unsigned w) { return __uint_as_float(w & 0xffff0000u); }
__device__ __forceinline__ int cond_of_pm(int pm) { return pm < 16 ? 8 : ((pm - 16) >> 3); }
__device__ __forceinline__ float sigmoidf_(float x) { return __builtin_amdgcn_rcpf(1.0f + __builtin_amdgcn_exp2f(-1.4426950408889634f * x)); }


struct EpiSwiglu {
    static constexpr bool PERM = true, AFTER_DRAIN = false;
    bf16_t* O;
    __device__ __forceinline__ void operator()(const f32x4 (&acc)[2][2][4][2], const Unit& u, int wr, int wc, int fr, int fq) const {
        asm volatile("" : "+v"(fr), "+v"(fq));
        const int row0 = u.pm * BM + wr * 64 + fr, col0 = u.pn * 128 + wc * 32 + 8 * fq;
#pragma unroll
        for (int ai = 0; ai < 2; ++ai)
#pragma unroll
            for (int m = 0; m < 4; ++m) {
                bf16_t* rowp = O + (size_t)(row0 + ai * HALF + m * 16) * FFD + col0;
                float v[8];
#pragma unroll
                for (int n = 0; n < 2; ++n)
#pragma unroll
                    for (int j = 0; j < 4; ++j) { const float g = acc[ai][0][m][n][j], up = acc[ai][1][m][n][j]; v[n * 4 + j] = g * sigmoidf_(g) * up; }
                u32x4 w; w.x = cvt_pk_bf16(v[0], v[1]); w.y = cvt_pk_bf16(v[2], v[3]); w.z = cvt_pk_bf16(v[4], v[5]); w.w = cvt_pk_bf16(v[6], v[7]);
                *(u32x4*)rowp = w;
            }
    }
};

struct EpiResid {
    static constexpr bool PERM = false, AFTER_DRAIN = false;
    const float* base; float* out; const float* gate; float gs;
    __device__ __forceinline__ void operator()(const f32x4 (&acc)[2][2][4][2], const Unit& u, int wr, int wc, int fr, int fq) const {
        asm volatile("" : "+v"(fr), "+v"(fq));
        const float* gv = gate + (size_t)cond_of_pm(u.pm) * 9216;
        const int col0 = u.pn * BM + (u.nhalf == 1 ? HALF : 0) + wc * 32 + 4 * fq;
        f32x4 g4[2][2];
#pragma unroll
        for (int bj = 0; bj < 2; ++bj)
#pragma unroll
            for (int n = 0; n < 2; ++n) g4[bj][n] = *(const f32x4*)(gv + col0 + bj * HALF + n * 16) * gs;
#pragma unroll
        for (int ai = 0; ai < 2; ++ai)
#pragma unroll
            for (int m = 0; m < 4; ++m) { if (ai == 1 && u.half >= 0) break;
                const size_t off = (size_t)(u.pm * BM + (u.half == 1 ? HALF : 0) + ai * HALF + wr * 64 + m * 16 + fr) * DM + col0;
#pragma unroll
                for (int bj = 0; bj < 2; ++bj) { if (bj == 1 && u.nhalf >= 0) break;
#pragma unroll
                    for (int n = 0; n < 2; ++n) { const f32x4 b = *(const f32x4*)(base + off + bj * HALF + n * 16);
                        *(f32x4*)(out + off + bj * HALF + n * 16) = b + g4[bj][n] * acc[ai][bj][m][n]; } }
            }
    }
};

struct EpiDelta {
    static constexpr bool PERM = true, AFTER_DRAIN = false;
    bf16_t* DL; const float* gate; float gs;
    __device__ __forceinline__ void operator()(const f32x4 (&acc)[2][2][4][2], const Unit& u, int wr, int wc, int fr, int fq) const {
        asm volatile("" : "+v"(fr), "+v"(fq));
        const float* gv = gate + (size_t)cond_of_pm(u.pm) * 9216;
        const int row0 = u.pm * BM + (u.half == 1 ? HALF : 0) + wr * 64 + fr, col0 = u.pn * BM + (u.nhalf == 1 ? HALF : 0) + wc * 32 + 8 * fq;
        f32x4 g4[2][2];
#pragma unroll
        for (int bj = 0; bj < 2; ++bj)
#pragma unroll
            for (int n = 0; n < 2; ++n) g4[bj][n] = *(const f32x4*)(gv + col0 + bj * HALF + n * 4) * gs;
#pragma unroll
        for (int ai = 0; ai < 2; ++ai)
#pragma unroll
            for (int m = 0; m < 4; ++m) { if (ai == 1 && u.half >= 0) break;
                bf16_t* rowp = DL + (size_t)(row0 + ai * HALF + m * 16) * DM + col0;
#pragma unroll
                for (int bj = 0; bj < 2; ++bj) { if (bj == 1 && u.nhalf >= 0) break;
                    const f32x4 v0 = g4[bj][0] * acc[ai][bj][m][0], v1 = g4[bj][1] * acc[ai][bj][m][1];
                    u32x4 w; w.x = cvt_pk_bf16(v0[0], v0[1]); w.y = cvt_pk_bf16(v0[2], v0[3]); w.z = cvt_pk_bf16(v1[0], v1[1]); w.w = cvt_pk_bf16(v1[2], v1[3]);
                    *(u32x4*)(rowp + bj * HALF) = w; } }
    }
};

struct EpiProj {
    static constexpr bool PERM = true, AFTER_DRAIN = false;
    bf16_t *Q, *K, *V, *UP, *UTs, *UTp; float *stk, *stv; const float *qg, *kg;
    __device__ __forceinline__ void operator()(const f32x4 (&acc)[2][2][4][2], const Unit& u, int wr, int wc, int fr, int fq) const {
        asm volatile("" : "+v"(fr), "+v"(fq));
        const int pn = u.pn, pm = u.pm; const bool latent = pm >= 16; const int rt0 = wr * 64 + fr;
#ifndef PJ
#define PJ 7
#endif
        if (pn < 8 && (PJ & 1)) {
            const bool isk = pn >= 4; const int u64 = 4 * (pn & 3) + wc;
            const float* gsrc = isk ? kg : qg; bf16_t* dst = isk ? K : Q;
            f32x4 gv[2][2];
#pragma unroll
            for (int bj = 0; bj < 2; ++bj)
#pragma unroll
                for (int n = 0; n < 2; ++n) gv[bj][n] = *(const f32x4*)(gsrc + 32 * bj + 16 * n + 4 * fq);
            float invrev[4];
#pragma unroll
            for (int j = 0; j < 4; ++j) invrev[j] = __builtin_amdgcn_exp2f(-(float)(4 * fq + j) * (13.287712379549449f / 16.0f)) * 0.15915494309189535f;
#pragma unroll
            for (int ai = 0; ai < 2; ++ai)
#pragma unroll
                for (int m = 0; m < 4; ++m) {
                    const int rt = ai * HALF + rt0 + m * 16, row = pm * BM + rt;
                    float ss = 0.f;
#pragma unroll
                    for (int bj = 0; bj < 2; ++bj)
#pragma unroll
                        for (int n = 0; n < 2; ++n) { const f32x4 x = acc[ai][bj][m][n]; ss += (x[0] * x[0] + x[1] * x[1]) + (x[2] * x[2] + x[3] * x[3]); }
                    ss += __shfl_xor(ss, 16); ss += __shfl_xor(ss, 32);
                    const float rstd = __builtin_amdgcn_rsqf(ss * (1.0f / 64.0f) + 1e-6f);
                    f32x4 y[2][2];
#pragma unroll
                    for (int bj = 0; bj < 2; ++bj)
#pragma unroll
                        for (int n = 0; n < 2; ++n) y[bj][n] = acc[ai][bj][m][n] * rstd * gv[bj][n];
                    if (latent) {
                        const int s = (row - T_PR) & 2047;
#pragma unroll
                        for (int bj = 0; bj < 2; ++bj) { const float pos = (float)(bj == 0 ? (s >> 6) : (s & 63));
#pragma unroll
                            for (int j = 0; j < 4; ++j) { const float rv = __builtin_amdgcn_fractf(pos * invrev[j]);
                                const float sn = __builtin_amdgcn_sinf(rv), cs = __builtin_amdgcn_cosf(rv);
                                const float x1 = y[bj][0][j], x2 = y[bj][1][j]; y[bj][0][j] = x1 * cs - x2 * sn; y[bj][1][j] = x1 * sn + x2 * cs; } }
                    }
#pragma unroll
                    for (int bj = 0; bj < 2; ++bj)
#pragma unroll
                        for (int n = 0; n < 2; ++n) { const int col = 64 * u64 + 32 * bj + 16 * n + 4 * fq;
                            u32x2 w; w.x = cvt_pk_bf16(y[bj][n][0], y[bj][n][1]); w.y = cvt_pk_bf16(y[bj][n][2], y[bj][n][3]);
                            *(u32x2*)(dst + (size_t)row * DM + col) = w;
                            if (isk && !latent) *(f32x4*)(stk + ((size_t)pm * 512 + rt) * DM + col) = y[bj][n]; }
                    asm volatile("" ::: "memory");
                }
        } else if (pn < 14 && (PJ & 2)) {
            const bool isv = pn < 12; bf16_t* dst = isv ? V : UP; const int ld = isv ? DM : 512; const int colt = (isv ? (pn - 8) : (pn - 12)) * BM + wc * 32 + 8 * fq;
#pragma unroll
            for (int ai = 0; ai < 2; ++ai)
#pragma unroll
                for (int m = 0; m < 4; ++m) { const int rt = ai * HALF + rt0 + m * 16, row = pm * BM + rt;
#pragma unroll
                    for (int bj = 0; bj < 2; ++bj) { const f32x4 v0 = acc[ai][bj][m][0], v1 = acc[ai][bj][m][1];
                        u32x4 w; w.x = cvt_pk_bf16(v0[0], v0[1]); w.y = cvt_pk_bf16(v0[2], v0[3]); w.z = cvt_pk_bf16(v1[0], v1[1]); w.w = cvt_pk_bf16(v1[2], v1[3]);
                        *(u32x4*)(dst + (size_t)row * ld + colt + bj * HALF) = w;
                        if (isv && !latent) { float* sp = stv + ((size_t)pm * 512 + rt) * DM + colt + bj * HALF; *(f32x4*)sp = v0; *(f32x4*)(sp + 4) = v1; } }
                    asm volatile("" ::: "memory");
                }
        } else if (PJ & 4) {
            bf16_t* dst; int ldl;
            if (latent) { const int b = (pm - 16) >> 3; dst = UTs + (size_t)b * 512 * 2048 + ((pm - 16) & 7) * BM; ldl = 2048; }
            else { dst = UTp + (size_t)pm * 512 * 256; ldl = 256; }
            const int c0 = (pn - 14) * BM + wc * 32 + 8 * fq;
#pragma unroll
            for (int ai = 0; ai < 2; ++ai)
#pragma unroll
                for (int m = 0; m < 4; ++m) { const int rt = ai * HALF + rt0 + m * 16;
#pragma unroll
                    for (int bj = 0; bj < 2; ++bj)
#pragma unroll
                        for (int n = 0; n < 2; ++n)
#pragma unroll
                            for (int j = 0; j < 4; j += 2) { const unsigned w = cvt_pk_bf16(acc[ai][bj][m][n][j], acc[ai][bj][m][n][j + 1]);
                                const int c = c0 + bj * HALF + 4 * n + j;
                                dst[(size_t)c * ldl + rt] = (bf16_t)(w & 0xffffu); dst[(size_t)(c + 1) * ldl + rt] = (bf16_t)(w >> 16); }
                    asm volatile("" ::: "memory");
                }
        }
    }
};

struct EpiFourier {
    static constexpr bool PERM = true, AFTER_DRAIN = false;
    bf16_t* Z; int lshift, tokbase, seqlen;
    __device__ __forceinline__ void operator()(const f32x4 (&acc)[2][2][4][2], const Unit& u, int wr, int wc, int fr, int fq) const {
        asm volatile("" : "+v"(fr), "+v"(fq));
        const int which = u.pm >> lshift, lt = u.pm & ((1 << lshift) - 1), b = u.pn >> 1, ct = u.pn & 1;
        const int row0 = tokbase + b * seqlen + lt * BM + wr * 64 + fr, col0 = which * 512 + ct * BM + wc * 32 + 8 * fq;
#pragma unroll
        for (int ai = 0; ai < 2; ++ai)
#pragma unroll
            for (int m = 0; m < 4; ++m) { bf16_t* rowp = Z + (size_t)(row0 + ai * HALF + m * 16) * DM + col0;
#pragma unroll
                for (int bj = 0; bj < 2; ++bj) { const f32x4 v0 = acc[ai][bj][m][0], v1 = acc[ai][bj][m][1];
                    u32x4 w; w.x = cvt_pk_bf16(v0[0], v0[1]); w.y = cvt_pk_bf16(v0[2], v0[3]); w.z = cvt_pk_bf16(v1[0], v1[1]); w.w = cvt_pk_bf16(v1[2], v1[3]);
                    *(u32x4*)(rowp + bj * HALF) = w; } }
    }
};

struct EpiMerge {
    static constexpr bool PERM = true, AFTER_DRAIN = false;
    bf16_t* G; bf16_t* TS; bf16_t* MB; int mode;
    __device__ __forceinline__ void operator()(const f32x4 (&acc)[2][2][4][2], const Unit& u, int wr, int wc, int fr, int fq) const {
        asm volatile("" : "+v"(fr), "+v"(fq));
        const int row0 = u.pm * BM + (u.half == 1 ? HALF : 0) + wr * 64 + fr, col0 = u.pn * BM + (u.nhalf == 1 ? HALF : 0) + wc * 32 + 8 * fq;
#pragma unroll
        for (int ai = 0; ai < 2; ++ai)
#pragma unroll
            for (int m = 0; m < 4; ++m) { if (ai == 1 && u.half >= 0) break;
                const size_t off = (size_t)(row0 + ai * HALF + m * 16) * DM + col0;
#pragma unroll
                for (int bj = 0; bj < 2; ++bj) { if (bj == 1 && u.nhalf >= 0) break;
                    const f32x4 v0 = acc[ai][bj][m][0], v1 = acc[ai][bj][m][1]; const size_t o = off + bj * HALF;
                    if (mode == 0) {
                        u32x4 w; w.x = cvt_pk_bf16(sigmoidf_(v0[0]), sigmoidf_(v0[1])); w.y = cvt_pk_bf16(sigmoidf_(v0[2]), sigmoidf_(v0[3]));
                        w.z = cvt_pk_bf16(sigmoidf_(v1[0]), sigmoidf_(v1[1])); w.w = cvt_pk_bf16(sigmoidf_(v1[2]), sigmoidf_(v1[3]));
                        *(u32x4*)(G + o) = w;
                    } else {
                        const u32x4 g = *(const u32x4*)(G + o);
                        f32x4 r0 = (f32x4){bf_lo(g.x), bf_hi(g.x), bf_lo(g.y), bf_hi(g.y)} * v0, r1 = (f32x4){bf_lo(g.z), bf_hi(g.z), bf_lo(g.w), bf_hi(g.w)} * v1;
                        if (mode >= 2) { const u32x4 t = *(const u32x4*)(TS + o);
                            r0 += (f32x4){bf_lo(t.x), bf_hi(t.x), bf_lo(t.y), bf_hi(t.y)}; r1 += (f32x4){bf_lo(t.z), bf_hi(t.z), bf_lo(t.w), bf_hi(t.w)}; }
                        { u32x4 w; w.x = cvt_pk_bf16(r0[0], r0[1]); w.y = cvt_pk_bf16(r0[2], r0[3]); w.z = cvt_pk_bf16(r1[0], r1[1]); w.w = cvt_pk_bf16(r1[2], r1[3]); *(u32x4*)((mode == 3 ? MB : TS) + o) = w; }
                    } } }
    }
};
template <class Epi, class Sched, bool ALIGN_EPI = false, bool SP2 = false>
__device__ __forceinline__ void gemm_phase(PG8_LAS unsigned char* lds, const Gemm g, const Sched& S, const Epi& E) {
    int tid_l = threadIdx.x; asm volatile("" : "+v"(tid_l));
    const int tid = tid_l, wid = __builtin_amdgcn_readfirstlane(tid >> 6), lane = tid & 63, wr = wid >> 2, wc = wid & 3, fr = lane & 15, fq = lane >> 4;
    const int K = g.K, nt = K / BK;
    unsigned voffA[2], voffB[2];
#pragma unroll
    for (int i = 0; i < 2; ++i) { int R, C; stage_rc(tid * 16 + i * 8192, R, C); const int Rb = Epi::PERM ? ((R & ~31) + perm32(R & 31)) : R;
        voffA[i] = (unsigned)(R * K + C) * 2u; voffB[i] = (unsigned)(Rb * K + C) * 2u; }
    const size_t kstep = (size_t)(BK * 2);
    const size_t hstep = (size_t)HALF * K * 2;
    const size_t tstep = 2 * hstep;
    const unsigned ldsw = (unsigned)wid * 1024u;
    const int aoff = lds_byte(wr * 64 + fr, fq * 8), boff = lds_byte(wc * 32 + fr, fq * 8);
#define PG8_SA(b, h) (((b) * 2 + (h)) * HTB)
#define PG8_SB(b, h) ((4 + (b) * 2 + (h)) * HTB)
#define PG8_STAGE(bufoff, gbase, voff) do { _Pragma("unroll") for (int _i = 0; _i < 2; ++_i) \
        __builtin_amdgcn_global_load_lds((const unsigned*)((const char*)(gbase) + (voff)[_i]), (PG8_LAS unsigned*)(lds + (bufoff) + ldsw + _i * 8192), 16, 0, 0); } while (0)
#define PG8_LDA(dst, b, h) do { _Pragma("unroll") for (int m = 0; m < 4; ++m) _Pragma("unroll") for (int k = 0; k < 2; ++k) dst[m][k] = *(const PG8_LAS bf16x8*)(lds + PG8_SA(b, h) + aoff + m * 2048 + k * 1024); } while (0)
#define PG8_LDB(dst, b, h) do { _Pragma("unroll") for (int n = 0; n < 2; ++n) _Pragma("unroll") for (int k = 0; k < 2; ++k) dst[n][k] = *(const PG8_LAS bf16x8*)(lds + PG8_SB(b, h) + boff + n * 2048 + k * 1024); } while (0)
#define PG8_MMA(ai, bj, At, Bt) do { __builtin_amdgcn_s_setprio(1); _Pragma("unroll") for (int m = 0; m < 4; ++m) _Pragma("unroll") for (int n = 0; n < 2; ++n) _Pragma("unroll") for (int k = 0; k < 2; ++k) \
        acc[ai][bj][m][n] = __builtin_amdgcn_mfma_f32_16x16x32_bf16(Bt[n][k], At[m][k], acc[ai][bj][m][n], 0, 0, 0); __builtin_amdgcn_s_setprio(0); } while (0)
#define PG8_WAIT_V(n) asm volatile("s_waitcnt vmcnt(" #n ")" ::: "memory")
#define PG8_WAIT_L(n) asm volatile("s_waitcnt lgkmcnt(" #n ")" ::: "memory")
#define PG8_BAR __builtin_amdgcn_s_barrier()
#define PG8_SCHED __builtin_amdgcn_sched_barrier(0)
    Unit cur, nxt; int ui = 0;
    if (!S.next(0, cur)) return;
    f32x4 acc[2][2][4][2];
#pragma unroll
    for (int a = 0; a < 2; ++a)
#pragma unroll
        for (int b = 0; b < 2; ++b)
#pragma unroll
            for (int m = 0; m < 4; ++m)
#pragma unroll
                for (int n = 0; n < 2; ++n) acc[a][b][m][n] = (f32x4){0.f, 0.f, 0.f, 0.f};
    bf16x8 At[4][2], B0[2][2], B1[2][2];
    const char* cA = (const char*)g.A + (size_t)cur.pm * tstep + (cur.half == 1 ? hstep : (size_t)0); const char* cB = (const char*)g.Bt + (size_t)cur.pn * tstep + (cur.nhalf == 1 ? hstep : (size_t)0);
    size_t cbh = cur.nhalf >= 0 ? (size_t)0 : hstep;
    size_t ch = cur.half >= 0 ? (size_t)0 : hstep;
    S.a_ready(cur);
    if constexpr (SP2) {
        PG8_STAGE(PG8_SB(0, 0), cB, voffB); PG8_STAGE(PG8_SB(0, 1), cB + cbh, voffB); PG8_STAGE(PG8_SA(0, 0), cA, voffA); PG8_STAGE(PG8_SA(0, 1), cA + ch, voffA);
        if (wr == 1) PG8_BAR;
        PG8_WAIT_V(2); PG8_BAR;
        PG8_STAGE(PG8_SB(1, 0), cB + kstep, voffB); PG8_STAGE(PG8_SA(1, 0), cA + kstep, voffA); PG8_STAGE(PG8_SB(1, 1), cB + cbh + kstep, voffB);
        PG8_WAIT_V(6); PG8_BAR;
    } else {
        PG8_STAGE(PG8_SB(0, 0), cB, voffB); PG8_STAGE(PG8_SA(0, 0), cA, voffA); PG8_STAGE(PG8_SB(0, 1), cB + cbh, voffB); PG8_STAGE(PG8_SA(0, 1), cA + ch, voffA);
        if (wr == 1) PG8_BAR;
        PG8_WAIT_V(4); PG8_BAR;
        PG8_STAGE(PG8_SB(1, 0), cB + kstep, voffB); PG8_STAGE(PG8_SA(1, 0), cA + kstep, voffA); PG8_STAGE(PG8_SB(1, 1), cB + cbh + kstep, voffB);
        PG8_WAIT_V(6); PG8_BAR;
    }
    for (;;) {
        const bool has_next = S.next(ui + 1, nxt);
        const char* nA = has_next ? (const char*)g.A + (size_t)nxt.pm * tstep + (nxt.half == 1 ? hstep : (size_t)0) : cA; const char* nB = has_next ? (const char*)g.Bt + (size_t)nxt.pn * tstep + (nxt.nhalf == 1 ? hstep : (size_t)0) : cB;
        const size_t nh = has_next ? (nxt.half >= 0 ? (size_t)0 : hstep) : ch; const bool hm = cur.half >= 0;
        const size_t nbh = has_next ? (nxt.nhalf >= 0 ? (size_t)0 : hstep) : cbh; const bool nm = cur.nhalf >= 0;
        for (int t = 0; t < nt; t += 2) {
            const bool last = (t == nt - 2);
            const char* a1 = cA + (size_t)(t + 1) * kstep;
            const char* a2 = last ? nA : cA + (size_t)(t + 2) * kstep; const char* b2 = last ? nB : cB + (size_t)(t + 2) * kstep;
            const char* a3 = a2 + kstep; const char* b3 = b2 + kstep;
            if (last && has_next) S.a_ready(nxt);
            if constexpr (SP2) {
            PG8_LDB(B0, 0, 0); if (!nm) { PG8_LDB(B1, 0, 1); } PG8_SCHED; PG8_LDA(At, 0, 0); PG8_STAGE(PG8_SA(1, 1), a1 + ch, voffA);
            PG8_WAIT_V(8); PG8_WAIT_L(0); PG8_BAR; PG8_MMA(0, 0, At, B0); if (!nm) { PG8_MMA(0, 1, At, B1); } PG8_BAR; PG8_SCHED;
            if (!hm) { PG8_LDA(At, 0, 1); } PG8_STAGE(PG8_SB(0, 0), b2, voffB); PG8_STAGE(PG8_SB(0, 1), b2 + (last ? nbh : cbh), voffB); PG8_STAGE(PG8_SA(0, 0), a2, voffA);
            PG8_WAIT_V(8); PG8_WAIT_L(0); PG8_BAR; if (!hm) { PG8_MMA(1, 0, At, B0); if (!nm) { PG8_MMA(1, 1, At, B1); } } PG8_BAR; PG8_SCHED;
            PG8_LDB(B0, 1, 0); if (!nm) { PG8_LDB(B1, 1, 1); } PG8_SCHED; PG8_LDA(At, 1, 0); PG8_STAGE(PG8_SA(0, 1), a2 + (last ? nh : ch), voffA);
            PG8_WAIT_V(8); PG8_WAIT_L(0); PG8_BAR; PG8_MMA(0, 0, At, B0); if (!nm) { PG8_MMA(0, 1, At, B1); } PG8_BAR; PG8_SCHED;
            if (!hm) { PG8_LDA(At, 1, 1); } PG8_STAGE(PG8_SB(1, 0), b3, voffB); PG8_STAGE(PG8_SB(1, 1), b3 + (last ? nbh : cbh), voffB); PG8_STAGE(PG8_SA(1, 0), a3, voffA);
            PG8_WAIT_V(8); PG8_WAIT_L(0); PG8_BAR; if (!hm) { PG8_MMA(1, 0, At, B0); if (!nm) { PG8_MMA(1, 1, At, B1); } } PG8_BAR; PG8_SCHED;
            } else {
            PG8_LDB(B0, 0, 0); PG8_SCHED; PG8_LDA(At, 0, 0); PG8_STAGE(PG8_SA(1, 1), a1 + ch, voffA);
            PG8_WAIT_L(8); PG8_BAR; PG8_WAIT_L(0); PG8_MMA(0, 0, At, B0); PG8_BAR; PG8_SCHED;
            PG8_LDB(B1, 0, 1); PG8_STAGE(PG8_SB(0, 0), b2, voffB);
            PG8_BAR; PG8_WAIT_L(0); PG8_MMA(0, 1, At, B1); PG8_BAR;
            PG8_LDA(At, 0, 1); PG8_STAGE(PG8_SA(0, 0), a2, voffA);
            PG8_BAR; PG8_WAIT_L(0); PG8_MMA(1, 0, At, B0); PG8_BAR; PG8_SCHED;
            PG8_STAGE(PG8_SB(0, 1), b2 + (last ? nbh : cbh), voffB);
            PG8_WAIT_V(6); PG8_BAR; PG8_MMA(1, 1, At, B1); PG8_BAR;
            PG8_LDB(B0, 1, 0); PG8_SCHED; PG8_LDA(At, 1, 0); PG8_STAGE(PG8_SA(0, 1), a2 + (last ? nh : ch), voffA);
            PG8_WAIT_L(8); PG8_BAR; PG8_WAIT_L(0); PG8_MMA(0, 0, At, B0); PG8_BAR; PG8_SCHED;
            PG8_LDB(B1, 1, 1); PG8_STAGE(PG8_SB(1, 0), b3, voffB);
            PG8_BAR; PG8_WAIT_L(0); PG8_MMA(0, 1, At, B1); PG8_BAR;
            PG8_LDA(At, 1, 1); PG8_STAGE(PG8_SA(1, 0), a3, voffA);
            PG8_BAR; PG8_WAIT_L(0); PG8_MMA(1, 0, At, B0); PG8_BAR; PG8_SCHED;
            PG8_STAGE(PG8_SB(1, 1), b3 + (last ? nbh : cbh), voffB);
            PG8_WAIT_V(6); PG8_BAR; PG8_MMA(1, 1, At, B1); PG8_BAR;
            }
        }
        if constexpr (ALIGN_EPI) { if (wr == 0) PG8_BAR; }
        if constexpr (!Epi::AFTER_DRAIN) { E(acc, cur, wr, wc, fr, fq); S.done(cur); }
        if (!has_next) break;
#pragma unroll
        for (int a = 0; a < 2; ++a)
#pragma unroll
            for (int b = 0; b < 2; ++b)
#pragma unroll
                for (int m = 0; m < 4; ++m)
#pragma unroll
                    for (int n = 0; n < 2; ++n) acc[a][b][m][n] = (f32x4){0.f, 0.f, 0.f, 0.f};
        cur = nxt; cA = nA; cB = nB; ch = nh; cbh = nbh; ++ui;
        if constexpr (ALIGN_EPI) { if (wr == 1) PG8_BAR; }
    }
    PG8_WAIT_V(0);
    if constexpr (!ALIGN_EPI) { if (wr == 0) PG8_BAR; }
    PG8_BAR;
    if constexpr (Epi::AFTER_DRAIN) { E.fused(acc, cur, wr, wc, fr, fq, lds, wid, lane); S.done(cur); }
#undef PG8_SA
#undef PG8_SB
#undef PG8_STAGE
#undef PG8_LDA
#undef PG8_LDB
#undef PG8_MMA
#undef PG8_WAIT_V
#undef PG8_WAIT_L
#undef PG8_BAR
#undef PG8_SCHED
}
}

using pg8::sigmoidf_; using pg8::bf_lo; using pg8::bf_hi;
namespace att {
using bf16 = unsigned short;
using bf16x8 = __attribute__((ext_vector_type(8))) short;
using s16x4  = __attribute__((ext_vector_type(4))) short;
using f32x16 = __attribute__((ext_vector_type(16))) float;
using u32x4  = __attribute__((ext_vector_type(4))) unsigned;
constexpr int NW = 8, QBLK = 32, KVBLK = 64, LDK = 1024;
constexpr float SCALE = 0.125f, THR = 8.f;
constexpr int SHM_V = KVBLK * 128 * 2, SHM_K = KVBLK * 128 * 2, SHM_ATTN = 2 * SHM_V + 2 * SHM_K + NW * 64 * 4;
#define KSWZ(row, colB) ((row) * 256 + ((colB) ^ (((row) & 7) << 4)))
#define SBAR() __builtin_amdgcn_sched_barrier(0)
__device__ __forceinline__ int crow(int r, int hi) { return (r & 3) + 8 * (r >> 2) + 4 * hi; }
__device__ __forceinline__ unsigned cvtpk(float lo, float hi) { unsigned r; asm volatile("v_cvt_pk_bf16_f32 %0, %1, %2" : "=v"(r) : "v"(lo), "v"(hi)); return r; }
__device__ __forceinline__ bf16x8 ld8(const bf16* p) { return *reinterpret_cast<const bf16x8*>(p); }

__device__ __forceinline__ void partialSM(f32x16& p0, f32x16& p1, float& m_reg, float& mn, float& alpha) {
  constexpr float C = SCALE * 1.4426950408889634f;
  alpha = 1.f; mn = 0.f;
#pragma unroll
  for (int r = 0; r < 16; ++r) p0[r] = fmaf(p0[r], C, -8.0f);
#pragma unroll
  for (int r = 0; r < 16; ++r) p1[r] = fmaf(p1[r], C, -8.0f);
#pragma unroll
  for (int r = 0; r < 16; ++r) p0[r] = __builtin_amdgcn_exp2f(p0[r]);
}
__device__ __forceinline__ void finishSM(f32x16& p0, f32x16& p1, float alpha, float& l_reg, bf16x8& pa0, bf16x8& pa1, bf16x8& pa2, bf16x8& pa3) {
#pragma unroll
  for (int r = 0; r < 16; ++r) p1[r] = __builtin_amdgcn_exp2f(p1[r]);
  float ps = 0;
#pragma unroll
  for (int r = 0; r < 16; ++r) ps += p0[r];
#pragma unroll
  for (int r = 0; r < 16; ++r) ps += p1[r];
  { auto rr = __builtin_amdgcn_permlane32_swap(__float_as_uint(ps), __float_as_uint(ps), false, false);
    ps = __uint_as_float(rr[0]) + __uint_as_float(rr[1]); }
  l_reg = l_reg * alpha + ps;
#define PK4(P, BASE, OUT) do { unsigned a0 = cvtpk(P[BASE + 0], P[BASE + 1]), a1 = cvtpk(P[BASE + 2], P[BASE + 3]);   \
    unsigned b0 = cvtpk(P[BASE + 4], P[BASE + 5]), b1 = cvtpk(P[BASE + 6], P[BASE + 7]);                              \
    auto r0 = __builtin_amdgcn_permlane32_swap(a0, b0, false, false); auto r1 = __builtin_amdgcn_permlane32_swap(a1, b1, false, false); \
    u32x4 w = {r0[0], r1[0], r0[1], r1[1]}; OUT = *reinterpret_cast<bf16x8*>(&w); } while (0)
  PK4(p0, 0, pa0); PK4(p0, 8, pa1); PK4(p1, 0, pa2); PK4(p1, 8, pa3);
#undef PK4
}
__device__ __forceinline__ void qkt(f32x16& p0, f32x16& p1, const bf16* Ks, const bf16x8* qr, int r32, int hi, int map) {
  p0 = f32x16{}; p1 = f32x16{};
#pragma unroll
  for (int d0 = 0; d0 < 4; ++d0) { int cb = (map * 64 + d0 * 16 + hi * 8) * 2;
    bf16x8 b0 = *reinterpret_cast<const bf16x8*>((const char*)Ks + KSWZ(r32, cb));
    bf16x8 b1 = *reinterpret_cast<const bf16x8*>((const char*)Ks + KSWZ(32 + r32, cb));
    p0 = __builtin_amdgcn_mfma_f32_32x32x16_bf16(b0, qr[d0], p0, 0, 0, 0);
    p1 = __builtin_amdgcn_mfma_f32_32x32x16_bf16(b1, qr[d0], p1, 0, 0, 0); }
}
__device__ __forceinline__ int v_st(int k, int c) { const int kk = (k & ~0xC) | ((k & 4) << 1) | ((k & 8) >> 1); return ((kk >> 3) * 4 + (c >> 5)) * 512 + ((kk & 7) * 32 + (c & 31)) * 2; }
__device__ __forceinline__ int v_rd_base(int lane) { return ((lane & 3) << 3) | (((lane >> 2) & 3) << 6) | (((lane >> 4) & 1) << 5) | (((lane >> 5) & 1) << 8); }
constexpr int v_rd_off(int d0, int ks, int half) { return d0 * 512 + ks * 4096 + half * 2048; }
template <int OFF> __device__ __forceinline__ s16x4 tr_read(int vb) {
  s16x4 r; asm volatile("ds_read_b64_tr_b16 %0, %1 offset:%2" : "=&v"(r) : "v"(vb), "i"(OFF) : "memory"); return r;
}
template <int D0> __device__ __forceinline__ void pv_one(f32x16& od, int vb, bf16x8 pa0, bf16x8 pa1, bf16x8 pa2, bf16x8 pa3) {
  const s16x4 l0 = tr_read<v_rd_off(D0, 0, 0)>(vb), h0 = tr_read<v_rd_off(D0, 0, 1)>(vb), l1 = tr_read<v_rd_off(D0, 1, 0)>(vb), h1 = tr_read<v_rd_off(D0, 1, 1)>(vb);
  const s16x4 l2 = tr_read<v_rd_off(D0, 2, 0)>(vb), h2 = tr_read<v_rd_off(D0, 2, 1)>(vb), l3 = tr_read<v_rd_off(D0, 3, 0)>(vb), h3 = tr_read<v_rd_off(D0, 3, 1)>(vb);
  asm volatile("s_waitcnt lgkmcnt(0)" ::: "memory"); SBAR();
#define PK(L, H) (bf16x8){L[0], L[1], L[2], L[3], H[0], H[1], H[2], H[3]}
  od = __builtin_amdgcn_mfma_f32_32x32x16_bf16(pa0, PK(l0, h0), od, 0, 0, 0);
  od = __builtin_amdgcn_mfma_f32_32x32x16_bf16(pa1, PK(l1, h1), od, 0, 0, 0);
  od = __builtin_amdgcn_mfma_f32_32x32x16_bf16(pa2, PK(l2, h2), od, 0, 0, 0);
  od = __builtin_amdgcn_mfma_f32_32x32x16_bf16(pa3, PK(l3, h3), od, 0, 0, 0);
#undef PK
}
__device__ __forceinline__ void pv_d0(f32x16* o, int vb, bf16x8 pa0, bf16x8 pa1, bf16x8 pa2, bf16x8 pa3) {
  pv_one<0>(o[0], vb, pa0, pa1, pa2, pa3); pv_one<1>(o[1], vb, pa0, pa1, pa2, pa3); pv_one<2>(o[2], vb, pa0, pa1, pa2, pa3); pv_one<3>(o[3], vb, pa0, pa1, pa2, pa3);
}

__device__ __forceinline__ void attn_unit(const bf16* Qh, const bf16* Kc, const bf16* Vc, const bf16* Ko, const bf16* Vo, int nctx, int NT,
                                          bf16* Out, const float* sg, float lam, float osc, char* lds) {
  int tid_l = threadIdx.x; asm volatile("" : "+v"(tid_l));
  const int tid = tid_l, wid = tid >> 6, lane = tid & 63, r32 = lane & 31, hi = lane >> 5, map = wid & 1, pair = wid >> 1;
  bf16* V_lds = (bf16*)lds; bf16* K_lds = (bf16*)(lds + 2 * SHM_V);
  float* ws = (float*)(lds + 2 * SHM_V + 2 * SHM_K) + wid * 64; float* li_l = ws; float* al_l = ws + 32;
  float m_reg = -1e30f, l_reg = 0; f32x16 o[4] = {}; bf16x8 qr[4];
  const bf16* Qw = Qh + (long)(pair * QBLK + r32) * LDK + map * 64 + hi * 8;
#pragma unroll
  for (int d0 = 0; d0 < 4; ++d0) qr[d0] = ld8(Qw + d0 * 16);
  const int sr = tid >> 4, sc = (tid & 15) * 8, vst0 = v_st(sr, sc), vst1 = v_st(32 + sr, sc);
  const int vb0 = (int)(uintptr_t)V_lds + v_rd_base(lane);
  struct { bf16x8 vs0, vs1, ks0, ks1; } sr_[2];
#define KT(t) (((t) < nctx) ? (Kc + (long)(t) * (KVBLK * LDK)) : (Ko + (long)((t) - nctx) * (KVBLK * LDK)))
#define VT(t) (((t) < nctx) ? (Vc + (long)(t) * (KVBLK * LDK)) : (Vo + (long)((t) - nctx) * (KVBLK * LDK)))
#define SLOAD(i, t) do { const bf16* kt_ = KT(t); const bf16* vt_ = VT(t); sr_[i].vs0 = ld8(&vt_[(long)(sr) * LDK + sc]); sr_[i].vs1 = ld8(&vt_[(long)(32 + sr) * LDK + sc]); \
    sr_[i].ks0 = ld8(&kt_[(long)(sr) * LDK + sc]); sr_[i].ks1 = ld8(&kt_[(long)(32 + sr) * LDK + sc]); } while (0)
#define SWRITE(b, i) do { *(bf16x8*)((char*)V_lds + (b) * SHM_V + vst0) = sr_[i].vs0;          \
    *(bf16x8*)((char*)V_lds + (b) * SHM_V + vst1) = sr_[i].vs1; int kc = sc * 2;               \
    *(bf16x8*)((char*)K_lds + (b) * SHM_K + KSWZ(sr, kc)) = sr_[i].ks0;                       \
    *(bf16x8*)((char*)K_lds + (b) * SHM_K + KSWZ(32 + sr, kc)) = sr_[i].ks1; } while (0)
#define SWAIT() asm volatile("s_waitcnt vmcnt(4)" ::: "memory")
#define RESC(a) do { } while (0)
  f32x16 pA0, pA1, pB0, pB1; float mnA, mnB, alA, alB; bf16x8 pa0, pa1, pa2, pa3;
  constexpr int SE = 0, SO = 1;
  SLOAD(SE, 0); asm volatile("s_waitcnt vmcnt(0)" ::: "memory"); SWRITE(0, SE); __syncthreads();
  qkt(pA0, pA1, K_lds, qr, r32, hi, map); partialSM(pA0, pA1, m_reg, mnA, alA);
  SLOAD(SO, 1); if (2 < NT) SLOAD(SE, 2);
  SWAIT(); SWRITE(1, SO); __syncthreads();
  for (int j = 1; j + 1 < NT; j += 2) {
    SBAR(); qkt(pB0, pB1, (bf16*)((char*)K_lds + SHM_K), qr, r32, hi, map);
    finishSM(pA0, pA1, alA, l_reg, pa0, pa1, pa2, pa3); SBAR();
    SLOAD(SO, j + 2); SBAR();
    pv_d0(o, vb0, pa0, pa1, pa2, pa3); partialSM(pB0, pB1, m_reg, mnB, alB);
    __syncthreads(); SWAIT(); SWRITE(0, SE);
    RESC(alB); __syncthreads();
    SBAR(); qkt(pA0, pA1, K_lds, qr, r32, hi, map);
    finishSM(pB0, pB1, alB, l_reg, pa0, pa1, pa2, pa3); SBAR();
    if (j + 3 < NT) SLOAD(SE, j + 3); SBAR();
    pv_d0(o, vb0 + (int)SHM_V, pa0, pa1, pa2, pa3); partialSM(pA0, pA1, m_reg, mnA, alA);
    __syncthreads(); SWAIT(); SWRITE(1, SO);
    RESC(alA); __syncthreads();
  }
  SBAR(); qkt(pB0, pB1, (bf16*)((char*)K_lds + SHM_K), qr, r32, hi, map);
  finishSM(pA0, pA1, alA, l_reg, pa0, pa1, pa2, pa3); SBAR();
  pv_d0(o, vb0, pa0, pa1, pa2, pa3); partialSM(pB0, pB1, m_reg, mnB, alB);
  __syncthreads(); RESC(alB);
  finishSM(pB0, pB1, alB, l_reg, pa0, pa1, pa2, pa3); SBAR();
  pv_d0(o, vb0 + (int)SHM_V, pa0, pa1, pa2, pa3);
  if (hi == 0) li_l[r32] = l_reg; asm volatile("s_waitcnt lgkmcnt(0)" ::: "memory");
  float rli[16];
#pragma unroll
  for (int r = 0; r < 16; ++r) rli[r] = __builtin_amdgcn_rcpf(li_l[crow(r, hi)]);
#pragma unroll
  for (int d0 = 0; d0 < 4; ++d0)
#pragma unroll
    for (int r = 0; r < 16; ++r) o[d0][r] *= rli[r];
  __syncthreads();
  float* xch = (float*)lds + pair * 4096;
  if (map == 1) {
#pragma unroll
    for (int d0 = 0; d0 < 4; ++d0)
#pragma unroll
      for (int r = 0; r < 16; ++r) xch[(r * 4 + d0) * 64 + lane] = o[d0][r];
  }
  __syncthreads();
  if (map == 0) {
    float gsub[4];
#pragma unroll
    for (int d0 = 0; d0 < 4; ++d0) gsub[d0] = sg[d0 * 32 + r32] * osc;
#pragma unroll
    for (int r = 0; r < 16; ++r) {
      float ss = 0.f;
#pragma unroll
      for (int d0 = 0; d0 < 4; ++d0) { const float v = o[d0][r] - lam * xch[(r * 4 + d0) * 64 + lane]; o[d0][r] = v; ss += v * v; }
      ss += __shfl_xor(ss, 1); ss += __shfl_xor(ss, 2); ss += __shfl_xor(ss, 4); ss += __shfl_xor(ss, 8); ss += __shfl_xor(ss, 16);
      const float rstd = __builtin_amdgcn_rsqf(ss * (1.0f / 128.0f) + 1e-6f);
      bf16* orow = Out + (long)(pair * QBLK + crow(r, hi)) * LDK + r32;
#pragma unroll
      for (int d0 = 0; d0 < 4; ++d0) orow[d0 * 32] = (bf16)(cvtpk(o[d0][r] * rstd * gsub[d0], 0.f) & 0xffffu);
    }
  }
  __syncthreads();
#undef KT
#undef VT
#undef SLOAD
#undef SWRITE
#undef SWAIT
#undef RESC
}
#undef KSWZ
#undef SBAR
}
#define LAS __attribute__((address_space(3)))
typedef unsigned short bf16;
typedef float f32x4 __attribute__((ext_vector_type(4)));
typedef unsigned v4u __attribute__((ext_vector_type(4)));
typedef unsigned v2u __attribute__((ext_vector_type(2)));
constexpr int NWAVES = 8, NTHR = 512;
constexpr int T = 20480, TPR = 4096, D = 1024, FF = 2816;
constexpr size_t MiB = 1u << 20;
constexpr size_t WS_MOD = 1 * MiB;
constexpr size_t WS_W13T = 2 * MiB;
constexpr size_t WS_W2T = 24 * MiB;
constexpr size_t WS_WINT = 35 * MiB;
constexpr size_t WS_WGT = 43 * MiB;
constexpr size_t WS_WPAT = 49 * MiB, WS_WOUTT = 51 * MiB, WS_WPPT = 53 * MiB, WS_WFT = 54 * MiB;
constexpr size_t WS_CS2048 = 56 * MiB;
constexpr size_t WS_CS256 = 72 * MiB;
constexpr size_t WS_CK = 73 * MiB, WS_CV = 81 * MiB;
constexpr size_t WS_X = 89 * MiB;
constexpr size_t WS_H = 169 * MiB;
constexpr size_t WS_R = 209 * MiB;
constexpr size_t WS_Q = WS_R, WS_V = WS_R + 40 * MiB, WS_K = WS_R + 80 * MiB, WS_UP = WS_R + 140 * MiB, WS_UT = WS_R + 160 * MiB;
constexpr size_t WS_HID = WS_R;
constexpr size_t WS_DP = WS_K;
constexpr size_t WS_Z = WS_V;
constexpr size_t WS_MB = WS_K + 20 * MiB;
constexpr size_t WS_G = WS_UP;
constexpr size_t WS_END = WS_R + 180 * MiB;
constexpr int LDS_BYTES = 147456;

struct Args { const float* in[23]; float* out; unsigned char* ws; int ph_lo, ph_hi; };
enum { I_XP = 0, I_XS, I_CK, I_CV, I_C, I_CCTX, I_WADA, I_BADA, I_NORMG, I_W13, I_W2, I_WIN, I_QG, I_KG, I_LAMQK, I_SUBG, I_WPOOL, I_PSCALE, I_WGATE, I_WPA, I_WPP, I_WPF, I_WOUT };

__device__ __forceinline__ unsigned f2bf(float f) { unsigned u = __builtin_bit_cast(unsigned, f); return (u + 0x7fffu + ((u >> 16) & 1u)) >> 16; }
__device__ __forceinline__ unsigned pk2(float lo, float hi) { return f2bf(lo) | (f2bf(hi) << 16); }
__device__ __forceinline__ float wave_sum(float v) {
#pragma unroll
    for (int o = 1; o < 64; o <<= 1) v += __shfl_xor(v, o);
    return v;
}
__device__ __forceinline__ int rowmap(int kind, int L) {
    if (kind == 1) { const int up = L >= FF ? 1 : 0, hc = L - up * FF; return (hc >> 7) * 256 + up * 128 + (hc & 127); }
    if (kind == 2 && L < 2048) { const int pn = L >> 8, r = L & 255, wc = r >> 6, bj = (r >> 5) & 1, n = (r >> 4) & 1, fq = (r >> 2) & 3, j = r & 3; return pn * 256 + bj * 128 + wc * 32 + fq * 8 + n * 4 + j; }
    return L;
}
__device__ __forceinline__ void transpose_item(const float* W, int K, int N, bf16* WT, int kind, LAS float* scr, int item, int lane) {
    const int nblk = N / 32, kb = item / nblk, nb = item % nblk, k0 = 64 * kb, n0 = 32 * nb;
#pragma unroll 8
    for (int i = 0; i < 32; ++i) { const int kk = 2 * i + (lane >> 5); scr[kk * 33 + (lane & 31)] = __builtin_nontemporal_load(W + (size_t)(k0 + kk) * N + n0 + (lane & 31)); }
    asm volatile("s_waitcnt lgkmcnt(0)" ::: "memory");
    const int c = lane & 7;
#pragma unroll
    for (int j = 0; j < 4; ++j) { const int n = (lane >> 3) + 8 * j; const LAS float* s = scr + (8 * c) * 33 + n;
        v4u o; o.x = pk2(s[0 * 33], s[1 * 33]); o.y = pk2(s[2 * 33], s[3 * 33]); o.z = pk2(s[4 * 33], s[5 * 33]); o.w = pk2(s[6 * 33], s[7 * 33]);
        *(v4u*)(WT + (size_t)rowmap(kind, n0 + n) * K + k0 + 8 * c) = o; }
    asm volatile("s_waitcnt lgkmcnt(0)" ::: "memory");
}

__device__ __forceinline__ void adaln_phase(const Args& a, LAS unsigned char* lds, int tid) {
    LAS float* sc = (LAS float*)lds;
    LAS float* red = (LAS float*)(lds + 9 * 1024 * 4);
    for (int i = tid; i < 9 * 1024; i += NTHR) { const float v = i < 8192 ? a.in[I_C][i] : a.in[I_CCTX][i - 8192]; sc[i] = v * sigmoidf_(v); }
    __syncthreads();
    float* MOD = (float*)(a.ws + WS_MOD);
    const int col = tid & 31, ks = tid >> 5;
    for (int it = blockIdx.x; it < 2 * 288; it += gridDim.x) {
        const int l = it / 288, n0 = (it % 288) * 32;
        const float* W = a.in[I_WADA] + (size_t)l * 1024 * 9216 + n0 + col;
        float acc[9];
#pragma unroll
        for (int c = 0; c < 9; ++c) acc[c] = 0.f;
#pragma unroll 4
        for (int k = ks * 64; k < ks * 64 + 64; ++k) { const float w = W[(size_t)k * 9216];
#pragma unroll
            for (int c = 0; c < 9; ++c) acc[c] += sc[c * 1024 + k] * w; }
#pragma unroll
        for (int c = 0; c < 9; ++c) red[(ks * 9 + c) * 32 + col] = acc[c];
        __syncthreads();
        if (tid < 288) { const int c = tid >> 5; float s = a.in[I_BADA][l * 9216 + n0 + col];
#pragma unroll
            for (int q = 0; q < 16; ++q) s += red[(q * 9 + c) * 32 + col];
            MOD[((size_t)l * 9 + c) * 9216 + n0 + col] = s; }
        __syncthreads();
    }
}
__device__ __forceinline__ void prep_layer(const Args& a, int l, LAS unsigned char* lds, int gw, int NGW, int wave, int lane) {
    LAS float* scr = (LAS float*)(lds + wave * 16384);
    unsigned char* ws = a.ws;
    constexpr int I13 = (D / 64) * (2 * FF / 32), I2 = (FF / 64) * (D / 32), IIN = (D / 64) * (4096 / 32), IG = (D / 64) * (3072 / 32), ISQ = (D / 64) * (D / 32);
    constexpr int NIT = 2 * I13 + 2 * I2 + IIN + IG + 2 * ISQ;
    for (int it = gw; it < NIT; it += NGW) {
        int r = it;
        if (r < 2 * I13) { const int s = r / I13; transpose_item(a.in[I_W13] + ((size_t)l * 2 + s) * D * 2 * FF, D, 2 * FF, (bf16*)(ws + WS_W13T) + (size_t)s * 2 * FF * D, 1, scr, r % I13, lane); continue; } r -= 2 * I13;
        if (r < 2 * I2) { const int s = r / I2; transpose_item(a.in[I_W2] + ((size_t)l * 2 + s) * FF * D, FF, D, (bf16*)(ws + WS_W2T) + (size_t)s * D * FF, 0, scr, r % I2, lane); continue; } r -= 2 * I2;
        if (r < IIN) { transpose_item(a.in[I_WIN] + (size_t)l * D * 4096, D, 4096, (bf16*)(ws + WS_WINT), 2, scr, r, lane); continue; } r -= IIN;
        if (r < IG) { transpose_item(a.in[I_WGATE] + (size_t)l * D * 3072, D, 3072, (bf16*)(ws + WS_WGT), 0, scr, r, lane); continue; } r -= IG;
        if (r < ISQ) { transpose_item(a.in[I_WPA] + (size_t)l * D * D, D, D, (bf16*)(ws + WS_WPAT), 0, scr, r, lane); continue; } r -= ISQ;
        transpose_item(a.in[I_WOUT] + (size_t)l * D * D, D, D, (bf16*)(ws + WS_WOUTT), 0, scr, r, lane);
    }
    {
        const float* wpool = a.in[I_WPOOL] + (size_t)l * 4 * 128 * 128; const float* psc = a.in[I_PSCALE] + (size_t)l * 512; const float* wpp = a.in[I_WPP] + (size_t)l * 512 * D;
        bf16* WPPT = (bf16*)(ws + WS_WPPT);
        for (int it = gw; it < 16 * 64; it += NGW) {
            const int n = (it & 15) * 64 + lane, kc = it >> 4, g = kc >> 4, c0 = (kc & 15) * 8;
            float acc[8];
#pragma unroll
            for (int j = 0; j < 8; ++j) acc[j] = 0.f;
            for (int cp = 0; cp < 128; ++cp) { const float w = wpp[(size_t)(g * 128 + cp) * D + n] * psc[g * 128 + cp];
#pragma unroll
                for (int j = 0; j < 8; ++j) acc[j] += wpool[(g * 128 + c0 + j) * 128 + cp] * w; }
            v4u o; o.x = pk2(acc[0], acc[1]); o.y = pk2(acc[2], acc[3]); o.z = pk2(acc[4], acc[5]); o.w = pk2(acc[6], acc[7]);
            *(v4u*)(WPPT + (size_t)n * 512 + kc * 8) = o;
        }
        const float* wpf = a.in[I_WPF] + (size_t)l * 512 * D; bf16* WFT = (bf16*)(ws + WS_WFT);
        for (int it = gw; it < 16 * 128; it += NGW) {
            const int n = (it & 15) * 64 + lane, kc = it >> 4, which = kc >> 6, g = (kc >> 4) & 3, c0 = (kc & 15) * 8;
#pragma unroll
            for (int i = 0; i < 16; ++i) { const int e = lane + 64 * i, cp = e >> 3, j = e & 7; const float rv = (float)(((c0 + j) * cp) & 127) * (1.0f / 128.0f);
                scr[e] = which ? -__builtin_amdgcn_sinf(rv) : __builtin_amdgcn_cosf(rv); }
            asm volatile("s_waitcnt lgkmcnt(0)" ::: "memory");
            float acc[8];
#pragma unroll
            for (int j = 0; j < 8; ++j) acc[j] = 0.f;
#pragma unroll 4
            for (int cp = 0; cp < 128; ++cp) { const float w = wpf[(size_t)(g * 128 + cp) * D + n];
                const f32x4 t0 = *(const LAS f32x4*)(scr + cp * 8), t1 = *(const LAS f32x4*)(scr + cp * 8 + 4);
                acc[0] += t0[0] * w; acc[1] += t0[1] * w; acc[2] += t0[2] * w; acc[3] += t0[3] * w; acc[4] += t1[0] * w; acc[5] += t1[1] * w; acc[6] += t1[2] * w; acc[7] += t1[3] * w; }
            asm volatile("s_waitcnt lgkmcnt(0)" ::: "memory");
            const float sc_ = 0.08838834764831845f;
            v4u o; o.x = pk2(acc[0] * sc_, acc[1] * sc_); o.y = pk2(acc[2] * sc_, acc[3] * sc_); o.z = pk2(acc[4] * sc_, acc[5] * sc_); o.w = pk2(acc[6] * sc_, acc[7] * sc_);
            *(v4u*)(WFT + (size_t)n * 1024 + kc * 8) = o;
        }
    }
    {
        const int gt = gw * 64 + lane, NGT = NGW * 64;
        for (int i = gt; i < 2 * 524288; i += NGT) {
            const int which = i >= 524288, j = which ? i - 524288 : i, b = j >> 16, rem = j & 65535;
            const float* src = a.in[which ? I_CV : I_CK] + ((size_t)(b * 2 + l) * 512 * 1024) + (size_t)rem * 8;
            const f32x4 x0 = *(const f32x4*)src, x1 = *(const f32x4*)(src + 4);
            v4u o; o.x = pk2(x0[0], x0[1]); o.y = pk2(x0[2], x0[3]); o.z = pk2(x1[0], x1[1]); o.w = pk2(x1[2], x1[3]);
            *(v4u*)((bf16*)(ws + (which ? WS_CV : WS_CK)) + (size_t)j * 8) = o;
        }
    }
}
__device__ __forceinline__ void dft_matrices(const Args& a, int gt, int NGT) {
    for (int pass = 0; pass < 2; ++pass) {
        const int L = pass ? 256 : 2048, lg = pass ? 8 : 11; bf16* CS = (bf16*)(a.ws + (pass ? WS_CS256 : WS_CS2048));
        const float scl = pass ? 0.0625f : 0.022097086912079608f, invL = 1.0f / (float)L;
        const int nitem = 2 * L * L / 8;
        for (int i = gt; i < nitem; i += NGT) {
            const int r = i >> (lg - 3), l0 = (i & ((L >> 3) - 1)) * 8, which = r >> lg, lp = r & (L - 1);
            float v[8];
#pragma unroll
            for (int j = 0; j < 8; ++j) { const float rv = (float)((lp * (l0 + j)) & (L - 1)) * invL; v[j] = (which ? __builtin_amdgcn_sinf(rv) : __builtin_amdgcn_cosf(rv)) * scl; }
            v4u o; o.x = pk2(v[0], v[1]); o.y = pk2(v[2], v[3]); o.z = pk2(v[4], v[5]); o.w = pk2(v[6], v[7]);
            *(v4u*)(CS + (size_t)r * L + l0) = o;
        }
    }
}
__device__ __forceinline__ void rows_phase(const Args& a, int l, int sub, bool from_input, int gw, int NGW, int lane, const bf16* DL = nullptr) {
    const float* MOD = (const float*)(a.ws + WS_MOD) + (size_t)l * 9 * 9216;
    const float* ng = a.in[I_NORMG] + ((size_t)l * 3 + sub) * D;
    float* X = (float*)(a.ws + WS_X); bf16* H = (bf16*)(a.ws + WS_H);
    f32x4 g4[4];
#pragma unroll
    for (int j = 0; j < 4; ++j) g4[j] = *(const f32x4*)(ng + 4 * lane + 256 * j);
#define ROWPTR(m_) (from_input ? ((m_) < TPR ? a.in[I_XP] + (size_t)(m_) * D : a.in[I_XS] + (size_t)((m_) - TPR) * D) : X + (size_t)(m_) * D)
    f32x4 v[4], vn[4]; v2u dn[4];
    const int RPW = (T + NGW - 1) / NGW; const int m0 = gw * RPW; const int m1 = (m0 + RPW < T) ? m0 + RPW : T;
    f32x4 sc4[4], sh4[4]; int cbp = -1;
    if (m0 < m1) { const float* xr = ROWPTR(m0);
#pragma unroll
        for (int j = 0; j < 4; ++j) { vn[j] = __builtin_nontemporal_load((const f32x4*)(xr + 4 * lane + 256 * j)); if (DL) dn[j] = __builtin_nontemporal_load((const v2u*)(DL + (size_t)m0 * D + 4 * lane + 256 * j)); } }
    for (int m = m0; m < m1; ++m) {
        const int cb = m < TPR ? 8 : ((m - TPR) >> 11);
        if (cb != cbp) { cbp = cb; const float* sh = MOD + (size_t)cb * 9216 + (3 * sub) * D; const float* scp = sh + D;
#pragma unroll
            for (int j = 0; j < 4; ++j) { sc4[j] = *(const f32x4*)(scp + 4 * lane + 256 * j) + 1.0f; sh4[j] = *(const f32x4*)(sh + 4 * lane + 256 * j); } }
        float s = 0.f;
#pragma unroll
        for (int j = 0; j < 4; ++j) { v[j] = vn[j]; if (DL) v[j] += (f32x4){bf_lo(dn[j].x), bf_hi(dn[j].x), bf_lo(dn[j].y), bf_hi(dn[j].y)};
            s += (v[j][0] * v[j][0] + v[j][1] * v[j][1]) + (v[j][2] * v[j][2] + v[j][3] * v[j][3]); }
        if (m + 1 < m1) { const float* xr = ROWPTR(m + 1);
#pragma unroll
            for (int j = 0; j < 4; ++j) { vn[j] = __builtin_nontemporal_load((const f32x4*)(xr + 4 * lane + 256 * j)); if (DL) dn[j] = __builtin_nontemporal_load((const v2u*)(DL + (size_t)(m + 1) * D + 4 * lane + 256 * j)); } }
        if (DL) {
#pragma unroll
            for (int j = 0; j < 4; ++j) __builtin_nontemporal_store(v[j], (f32x4*)(X + (size_t)m * D + 4 * lane + 256 * j));
        }
        const float rstd = 1.0f / sqrtf(wave_sum(s) * (1.0f / D) + 1e-6f);
#pragma unroll
        for (int j = 0; j < 4; ++j) {
            const f32x4 y = v[j] * rstd * g4[j] * sc4[j] + sh4[j];
            v2u o; o.x = pk2(y[0], y[1]); o.y = pk2(y[2], y[3]);
            *(v2u*)(H + (size_t)m * D + 4 * lane + 256 * j) = o; }
    }
#undef ROWPTR
}
__device__ __forceinline__ void pool_phase(const Args& a, int gt, int NGT) {
    const bf16* UP = (const bf16*)(a.ws + WS_UP); bf16* DP = (bf16*)(a.ws + WS_DP);
    for (int i = gt; i < T * 64; i += NGT) {
        const int tok = i >> 6, ch = (i & 63) * 8, g = ch >> 7, half = 1 << g;
        int s0, L, s;
        if (tok < TPR) { L = 256; s0 = tok & ~255; s = tok & 255; } else { L = 2048; s0 = TPR + ((tok - TPR) & ~2047); s = (tok - TPR) & 2047; }
        const int lo = s - half < 0 ? 0 : s - half, hi = s + half > L ? L : s + half;
        float acc[8];
#pragma unroll
        for (int j = 0; j < 8; ++j) acc[j] = 0.f;
#pragma unroll
        for (int kb = 0; kb < 16; kb += 8) {
            v4u wv[8];
#pragma unroll
            for (int k = 0; k < 8; ++k) { int p = s - half + kb + k; p = p < lo ? lo : (p >= hi ? hi - 1 : p); wv[k] = *(const v4u*)(UP + (size_t)(s0 + p) * 512 + ch); }
#pragma unroll
            for (int k = 0; k < 8; ++k) { const int p = s - half + kb + k; const float m = (kb + k < 2 * half && p >= lo && p < hi) ? 1.0f : 0.0f; const v4u w = wv[k];
                acc[0] += m * bf_lo(w.x); acc[1] += m * bf_hi(w.x); acc[2] += m * bf_lo(w.y); acc[3] += m * bf_hi(w.y); acc[4] += m * bf_lo(w.z); acc[5] += m * bf_hi(w.z); acc[6] += m * bf_lo(w.w); acc[7] += m * bf_hi(w.w); }
            asm volatile("" ::: "memory");
        }
        const v4u w = *(const v4u*)(UP + (size_t)tok * 512 + ch); const float inv = 1.0f / (float)(hi - lo);
        v4u o; o.x = pk2(acc[0] * inv - bf_lo(w.x), acc[1] * inv - bf_hi(w.x)); o.y = pk2(acc[2] * inv - bf_lo(w.y), acc[3] * inv - bf_hi(w.y));
        o.z = pk2(acc[4] * inv - bf_lo(w.z), acc[5] * inv - bf_hi(w.z)); o.w = pk2(acc[6] * inv - bf_lo(w.w), acc[7] * inv - bf_hi(w.w));
        *(v4u*)(DP + (size_t)tok * 512 + ch) = o;
    }
}
__device__ __forceinline__ void attention_phase(const Args& a, int l, unsigned char* lds, int vcu, int G, bool dummy) {
    const att::bf16* Qb = (const att::bf16*)(a.ws + WS_Q); const att::bf16* Kb = (const att::bf16*)(a.ws + WS_K); const att::bf16* Vb = (const att::bf16*)(a.ws + WS_V);
    const att::bf16* CK = (const att::bf16*)(a.ws + WS_CK); const att::bf16* CV = (const att::bf16*)(a.ws + WS_CV);
    const float* lq = a.in[I_LAMQK] + (size_t)l * 256;
    float d1 = 0.f, d2 = 0.f;
    for (int i = 0; i < 64; ++i) { d1 += lq[i] * lq[64 + i]; d2 += lq[128 + i] * lq[192 + i]; }
    const float lam_init = l == 0 ? 0.2f : 0.35550906759f;
    const float lam = __expf(d1) - __expf(d2) + lam_init, osc = 1.0f - lam_init;
    const float* sg = a.in[I_SUBG] + (size_t)l * 128;
    for (int uidx = vcu; uidx < 1024 + 256; uidx += G) {
        int tok0, qb, h, nctx, NT; const att::bf16 *kc, *vc;
        if (uidx < 1024) { const int b = uidx >> 7; h = (uidx >> 4) & 7; qb = uidx & 15; tok0 = TPR + b * 2048; nctx = 8; NT = 40; kc = CK + (size_t)b * 512 * 1024; vc = CV + (size_t)b * 512 * 1024; }
        else { const int v = uidx - 1024, b = v >> 4; h = (v >> 1) & 7; qb = v & 1; tok0 = b * 256; nctx = 0; NT = 4; kc = CK; vc = CV; }
        const size_t hoff = (size_t)h * 128;
        att::attn_unit(Qb + (size_t)(tok0 + qb * 128) * 1024 + hoff, kc + hoff, vc + hoff, Kb + (size_t)tok0 * 1024 + hoff, Vb + (size_t)tok0 * 1024 + hoff, nctx, NT,
                       (dummy ? (att::bf16*)a.out : (att::bf16*)(a.ws + WS_Q)) + (size_t)(tok0 + qb * 128) * 1024 + hoff, sg, lam, osc, (char*)lds);
    }
}

#define XB_TMO      128
#define XB_XCNT(j)  (256  + 64 * (j))
#define XB_XSUB(j)  (1280 + 64 * (j))
#define XB_XGEN(j)  (2304 + 64 * (j))
#define XB_TOP      3328
#define XB_TOPGEN   3392
#define XCD_BAR_WORDS 3456
#define XB_SPIN_CAP (1u << 18)

__device__ __forceinline__ unsigned xb_ld(unsigned* p)              { return __hip_atomic_load(p, __ATOMIC_RELAXED, __HIP_MEMORY_SCOPE_AGENT); }
__device__ __forceinline__ unsigned xb_add(unsigned* p, unsigned v) { return __hip_atomic_fetch_add(p, v, __ATOMIC_RELAXED, __HIP_MEMORY_SCOPE_AGENT); }
__device__ __forceinline__ unsigned xb_xcc_id() { return (unsigned)__builtin_amdgcn_s_getreg((3 << 11) | 20) & 0xFu; }
#define XB_SPIN(cond, bar) do { unsigned _sp = 0; while (cond) { __builtin_amdgcn_s_sleep(1); \
    if ((++_sp & 255u) == 0u) { if (xb_ld(&(bar)[XB_TMO])) break; if (_sp > XB_SPIN_CAP) { atomicAdd(&(bar)[XB_TMO], 1u); break; } } } } while (0)

struct XcdBarrier {
    unsigned* bar; unsigned x;
    volatile LAS unsigned* st;
};

__device__ __forceinline__ XcdBarrier xcd_barrier_post(unsigned* bar, volatile LAS unsigned* st) {
    XcdBarrier b; b.bar = bar; b.x = xb_xcc_id(); b.st = st;
    if (threadIdx.x == 0) (void)xb_add(&bar[XB_XCNT(b.x)], 1u);
    return b;
}
__device__ __forceinline__ void xcd_barrier_complete(unsigned* bar, unsigned x, unsigned& nloc, unsigned& nx) {
    const unsigned G = gridDim.x * gridDim.y * gridDim.z;
    unsigned sum, cnt, mine, sp = 0u;
    for (;;) {
        sum = 0u; cnt = 0u; mine = 0u;
#pragma unroll
        for (unsigned j = 0; j < 16; ++j) { const unsigned c = xb_ld(&bar[XB_XCNT(j)]); sum += c; cnt += (c > 0u) ? 1u : 0u; mine = (j == x) ? c : mine; }
        if (sum == G) break;
        __builtin_amdgcn_s_sleep(1);
        if ((++sp & 255u) == 0u) { if (xb_ld(&bar[XB_TMO])) break; if (sp > XB_SPIN_CAP) { atomicAdd(&bar[XB_TMO], 1u); break; } }
    }
    nloc = mine > 0u ? mine : 1u; nx = cnt > 0u ? cnt : 1u;
}

__device__ __forceinline__ void xcd_barrier(const XcdBarrier& b) {
    asm volatile("s_waitcnt vmcnt(0)" ::: "memory");
    __syncthreads();
    if (threadIdx.x == 0) {
        unsigned* bar = b.bar;
        __builtin_amdgcn_s_waitcnt(0);
        unsigned nloc = b.st[0], nx = b.st[1];
        if (nloc == 0u) { xcd_barrier_complete(bar, b.x, nloc, nx); b.st[0] = nloc; b.st[1] = nx; }
        const unsigned old = xb_add(&bar[XB_XSUB(b.x)], 1u);
        const unsigned gen = old / nloc;
        if (old + 1u == (gen + 1u) * nloc) {
            __builtin_amdgcn_fence(__ATOMIC_RELEASE, "agent");
            asm volatile("s_waitcnt vmcnt(0)" ::: "memory");
            const unsigned og = xb_add(&bar[XB_TOP], 1u);
            const unsigned tg = og / nx;
            if (og + 1u == (tg + 1u) * nx) xb_add(&bar[XB_TOPGEN], 1u);
            else XB_SPIN(xb_ld(&bar[XB_TOPGEN]) == tg, bar);
            __builtin_amdgcn_fence(__ATOMIC_ACQUIRE, "agent");
            xb_add(&bar[XB_XGEN(b.x)], 1u);
            asm volatile("s_waitcnt vmcnt(0)" ::: "memory");
        } else {
            XB_SPIN(xb_ld(&bar[XB_XGEN(b.x)]) == gen, bar);
            __builtin_amdgcn_fence(__ATOMIC_ACQUIRE, "agent");
            asm volatile("s_waitcnt vmcnt(0)" ::: "memory");
        }
    }
    __syncthreads();
}

#ifndef PHMASK
#define PHMASK 0xffff
#endif
#ifndef REP_PRO
#define REP_PRO 1
#endif
#ifndef REP_ATT
#define REP_ATT 1
#endif
#ifndef REP_ROWS
#define REP_ROWS 1
#endif
#ifndef REP_PE
#define REP_PE 1
#endif
#ifndef REP_PA
#define REP_PA 1
#endif
#define PHON(b) ((PHMASK >> (b)) & 1)
__global__ void __launch_bounds__(NTHR, 2) fwd_mega(Args a) {
    extern __shared__ __attribute__((aligned(16))) unsigned char lds_raw[];
    LAS unsigned char* lds = (LAS unsigned char*)lds_raw;
    cg::grid_group grid = cg::this_grid();
    volatile LAS unsigned* MISC = (volatile LAS unsigned*)(lds + 131072 + 320);
    if (threadIdx.x < 32) MISC[threadIdx.x] = 0u;
    __syncthreads();
    XcdBarrier xbar = xcd_barrier_post((unsigned*)a.ws + 4096, MISC + 8);
    const int G = gridDim.x, bx = blockIdx.x, vcu = (G % 8 == 0) ? (bx % 8) * (G / 8) + bx / 8 : bx;
    unsigned char* ws = a.ws;
    bf16* const H = (bf16*)(ws + WS_H); float* const X = (float*)(ws + WS_X);
    for (int ph = a.ph_lo; ph < a.ph_hi; ++ph) {
        int tid_l = threadIdx.x; asm volatile("" : "+v"(tid_l));
        const int tid = tid_l, lane = tid & 63, wave = __builtin_amdgcn_readfirstlane(tid >> 6);
        const int gw = vcu * NWAVES + wave, NGW = G * NWAVES, gt = gw * 64 + lane, NGT = NGW * 64;
        if (ph == 0 && PHON(0)) {
            for (int rep = 0; rep < REP_PRO; ++rep) {
            adaln_phase(a, lds, tid);
            dft_matrices(a, gt, NGT);
            prep_layer(a, 0, lds, gw, NGW, wave, lane); }
        } else if (ph == 1 && PHON(1)) {
            rows_phase(a, 0, 0, true, gw, NGW, lane);
        } else if (ph == 13 && PHON(1)) {
            rows_phase(a, 1, 0, false, gw, NGW, lane, (const bf16*)(ws + WS_UP));
            for (int rep = 0; rep < REP_PRO; ++rep) prep_layer(a, 1, lds, gw, NGW, wave, lane);
        } else {
            const int l = ph >= 14 ? 1 : 0, sp = ph - (l ? 14 : 2);
            const float* MOD = (const float*)(ws + WS_MOD) + (size_t)l * 9 * 9216;
            if ((sp == 0 || sp == 9) && PHON(2)) {
                const int s = sp == 0 ? 0 : 1;
                pg8::Gemm g{H, (const bf16*)(ws + WS_W13T) + (size_t)s * 2 * FF * D, T, 2 * FF, D}; pg8::StaticOrder S; S.init(T, 2 * FF, G, bx);
                pg8::EpiSwiglu E{(bf16*)(ws + WS_HID)};
                for (int rep = 0; rep < REP_PA; ++rep) pg8::gemm_phase<pg8::EpiSwiglu, pg8::StaticOrder, true, true>(lds, g, S, E);
            } else if ((sp == 1 || sp == 10) && PHON(3)) {
                const int s = sp == 1 ? 0 : 1; const bool last = (l == 1 && sp == 10);
                pg8::Gemm g{(const bf16*)(ws + WS_HID), (const bf16*)(ws + WS_W2T) + (size_t)s * D * FF, T, D, FF}; pg8::HalfOrder S; S.init(bx);
                if (last) { pg8::EpiResid E{X, a.out, MOD + 8 * D, 0.5f}; pg8::gemm_phase<pg8::EpiResid, pg8::HalfOrder, true, true>(lds, g, S, E); }
                else { pg8::EpiDelta E{(bf16*)(ws + WS_UP), MOD + (s == 0 ? 2 : 8) * D, 0.5f}; pg8::gemm_phase<pg8::EpiDelta, pg8::HalfOrder, true, true>(lds, g, S, E); }
            } else if ((sp == 2 || sp == 8) && PHON(1)) {
                rows_phase(a, l, sp == 2 ? 1 : 2, l == 0 && sp == 2, gw, NGW, lane, (const bf16*)(ws + WS_UP));
            } else if (sp == 3 && PHON(4)) {
                pg8::Gemm g{H, (const bf16*)(ws + WS_WINT), T, 4096, D}; pg8::StaticOrder S; S.init(T, 4096, G, bx);
                float* stk = a.out + (size_t)T * D + (size_t)l * 256 * D; float* stv = stk + (size_t)16 * 2 * 256 * D;
                pg8::EpiProj E{(bf16*)(ws + WS_Q), (bf16*)(ws + WS_K), (bf16*)(ws + WS_V), (bf16*)(ws + WS_UP), (bf16*)(ws + WS_UT), (bf16*)(ws + WS_UT) + (size_t)8 * 512 * 2048,
                               stk, stv, a.in[I_QG] + l * 64, a.in[I_KG] + l * 64};
                pg8::gemm_phase<pg8::EpiProj, pg8::StaticOrder, true, true>(lds, g, S, E);
            } else if (sp == 4 && PHON(5)) {
                for (int rep = REP_ATT - 1; rep >= 0; --rep) attention_phase(a, l, lds_raw, vcu, G, rep != 0);
            } else if (sp == 5 && PHON(6)) {
                pool_phase(a, gt, NGT);
                for (int kind = 0; kind < 2; ++kind) {
                    pg8::Gemm g; pg8::EpiFourier E; pg8::StaticOrder S;
                    if (kind == 0) { g = pg8::Gemm{(const bf16*)(ws + WS_CS2048), (const bf16*)(ws + WS_UT), 4096, 4096, 2048}; E = pg8::EpiFourier{(bf16*)(ws + WS_Z), 3, TPR, 2048}; }
                    else { g = pg8::Gemm{(const bf16*)(ws + WS_CS256), (const bf16*)(ws + WS_UT) + (size_t)8 * 512 * 2048, 512, 8192, 256}; E = pg8::EpiFourier{(bf16*)(ws + WS_Z), 0, 0, 256}; }
                    S.init(g.M, g.N, G, bx);
                    pg8::gemm_phase<pg8::EpiFourier, pg8::StaticOrder, true, true>(lds, g, S, E);
                }
            } else if (sp == 6 && PHON(7)) {
                for (int step6 = 0; step6 < 6 * REP_PE; ++step6) {
                    const int step = step6 % 6, br = step >> 1;
                    pg8::Gemm g; pg8::HalfOrder S; S.init(bx);
                    pg8::EpiMerge E{(bf16*)(ws + WS_G), (bf16*)a.out, (bf16*)(ws + WS_MB), 0};
                    if ((step & 1) == 0) g = pg8::Gemm{H, (const bf16*)(ws + WS_WGT) + (size_t)br * D * D, T, D, D};
                    else { E.mode = br + 1;
                        if (br == 0) g = pg8::Gemm{(const bf16*)(ws + WS_Q), (const bf16*)(ws + WS_WPAT), T, D, D};
                        else if (br == 1) g = pg8::Gemm{(const bf16*)(ws + WS_DP), (const bf16*)(ws + WS_WPPT), T, D, 512};
                        else g = pg8::Gemm{(const bf16*)(ws + WS_Z), (const bf16*)(ws + WS_WFT), T, D, D}; }
                    pg8::gemm_phase<pg8::EpiMerge, pg8::HalfOrder, true, true>(lds, g, S, E);
                }
            } else if (sp == 7 && PHON(8)) {
                pg8::Gemm g{(const bf16*)(ws + WS_MB), (const bf16*)(ws + WS_WOUTT), T, D, D}; pg8::HalfOrder S; S.init(bx);
                pg8::EpiDelta E{(bf16*)(ws + WS_UP), MOD + 5 * D, 1.0f};
                pg8::gemm_phase<pg8::EpiDelta, pg8::HalfOrder, true, true>(lds, g, S, E);
            }
        }
        if (ph + 1 < a.ph_hi) { if (a.ph_hi > 1000) grid.sync(); xcd_barrier(xbar); }
    }
}

constexpr int N_PHASES = 25;
#ifndef MK_ONE_LAUNCH
#define MK_ONE_LAUNCH 1
#endif
extern "C" void kernel_launch(void* const* d_in, const int* in_sizes, int n_in, void* d_out, int out_size, void* d_ws, size_t ws_size, hipStream_t stream) {
    static int grid = 0;
    if (grid == 0) {
        if (n_in != 23 || ws_size < WS_END) { fprintf(stderr, "kernel_launch: n_in %d ws %zu (need 23, >= %zu)\n", n_in, ws_size, (size_t)WS_END); grid = -1; return; }
        int dev = 0, cus = 0, per_cu = 0;
        hipGetDevice(&dev); hipDeviceGetAttribute(&cus, hipDeviceAttributeMultiprocessorCount, dev);
        if (hipFuncSetAttribute((const void*)fwd_mega, hipFuncAttributeMaxDynamicSharedMemorySize, LDS_BYTES) != hipSuccess) { fprintf(stderr, "kernel_launch: hipFuncSetAttribute failed\n"); grid = -1; return; }
        if (hipOccupancyMaxActiveBlocksPerMultiprocessor(&per_cu, (const void*)fwd_mega, NTHR, LDS_BYTES) != hipSuccess || per_cu < 1) { fprintf(stderr, "kernel_launch: occupancy query says %d\n", per_cu); per_cu = 1; }
        (void)hipGetLastError();
        if (cus != 256) { fprintf(stderr, "kernel_launch: built for a 256-CU device (got %d)\n", cus); grid = -1; return; }
        grid = cus * 1;
    }
    if (grid < 0) return;
    Args a{};
    for (int i = 0; i < 23; ++i) a.in[i] = (const float*)d_in[i];
    a.out = (float*)d_out; a.ws = (unsigned char*)d_ws;
#if MK_ONE_LAUNCH
    if (hipMemsetAsync(d_ws, 0, 65536, stream) != hipSuccess) { fprintf(stderr, "kernel_launch: memset failed\n"); return; }
    a.ph_lo = 0; a.ph_hi = N_PHASES;
    void* args[] = {&a};
    hipError_t e = hipLaunchCooperativeKernel((const void*)fwd_mega, dim3(grid), dim3(NTHR), args, LDS_BYTES, stream);
    if (e != hipSuccess) fprintf(stderr, "cooperative launch failed: %s (grid %d)\n", hipGetErrorString(e), grid);
#else
    for (int ph = 0; ph < N_PHASES; ++ph) {
        a.ph_lo = ph; a.ph_hi = ph + 1;
        hipLaunchKernelGGL(fwd_mega, dim3(grid), dim3(NTHR), LDS_BYTES, stream, a);
    }
#endif
}
```
